# Optimizing an MI355X kernel written in HIP

```python
import math
import jax, jax.numpy as jnp
from jax import lax
import numpy as np

D_MODEL = 1024
BATCH = 2
SEQ = 8192
DEPTH = 4
DEC_BATCH = 128
DEC_SEQ = 1
PAST_LEN = 8192
PAGE_SIZE = 128

N_A_LAYERS = DEPTH // 2
N_B_LAYERS = DEPTH - N_A_LAYERS
A_EXPAND = 128
A_HEADS = D_MODEL // A_EXPAND
A_DK = A_EXPAND
A_DV = D_MODEL // A_HEADS
A_CHUNK = 64
F_MIN = 1e-30
B_HEAD_DIM = 64
B_HEADS = D_MODEL // B_HEAD_DIM
B_KV_HEADS = 4
B_GROUPS = B_HEADS // B_KV_HEADS
WINDOW = 128
MASK_VALUE = -1e30
N_BUCKETS = 32
MAX_DISTANCE = 128
D_FF = -(-8 * D_MODEL // (3 * 256)) * 256
EPS = 1e-6

kernel_name = "yoco_hgrn2_swa_sink_adaln_decoder_step"


def rms_norm(x, g):
    x32 = x.astype(jnp.float32)
    y = x32 * lax.rsqrt(jnp.mean(x32 * x32, axis=-1, keepdims=True) + EPS)
    return y * g.astype(jnp.float32)


def modulate(x, g, shift, scale):
    y = rms_norm(x, g) * (1.0 + scale[:, None, :]) + shift[:, None, :]
    return y.astype(x.dtype)


def ada_params(c, w, b):
    return (jax.nn.silu(c) @ w + b).astype(jnp.float32)


def swiglu(x, w_in, w_out):
    gate, up = jnp.split(x @ w_in, 2, axis=-1)
    return (jax.nn.silu(gate) * up) @ w_out


def t5_bucket(dist):
    max_exact = N_BUCKETS // 2
    d = jnp.clip(dist, 0, WINDOW - 1)
    large = max_exact + (jnp.log(jnp.maximum(d, 1).astype(jnp.float32) / max_exact)
                         / math.log(MAX_DISTANCE / max_exact)
                         * (N_BUCKETS - max_exact)).astype(jnp.int32)
    large = jnp.clip(large, 0, N_BUCKETS - 1)
    return jnp.where(d < max_exact, d, large)


def rel_bias_for(dist, rel_bias):
    bias = rel_bias.astype(jnp.float32)[t5_bucket(dist)]
    q_len, k_len = dist.shape
    return bias.transpose(2, 0, 1).reshape(B_KV_HEADS, B_GROUPS, q_len, k_len)


def sink_softmax(logits, sinks):
    sink = sinks.astype(jnp.float32).reshape(B_KV_HEADS, B_GROUPS)[:, :, None, None]
    m = jnp.maximum(jnp.max(logits, axis=-1, keepdims=True), sink)
    p = jnp.exp(logits - m)
    denom = jnp.sum(p, axis=-1, keepdims=True) + jnp.exp(sink - m)
    return p / denom


def hgrn2_chunk_scan(q, k, v, log_f, s0, chunk):
    bsz, t, h, _ = q.shape
    dv = v.shape[-1]
    n = t // chunk

    def blocks(a):
        return a.reshape(bsz, n, chunk, h, a.shape[-1]).transpose(1, 0, 3, 2, 4)

    causal = jnp.tril(jnp.ones((chunk, chunk), dtype=bool))[None, None, :, :, None]

    def step(s, inp):
        qc, kc, vc, gc = inp
        b = jnp.cumsum(gc, axis=2)
        o_inter = jnp.einsum('bhtk,bhkv->bhtv', qc * jnp.exp(b), s)
        diff = b[:, :, :, None, :] - b[:, :, None, :, :]
        decay = jnp.where(causal, jnp.exp(jnp.minimum(diff, 0.0)), 0.0)
        att = jnp.einsum('bhtsk,bhtk,bhsk->bhts', decay, qc, kc)
        o = o_inter + jnp.einsum('bhts,bhsv->bhtv', att, vc)
        b_last = b[:, :, -1:, :]
        s = (jnp.exp(b_last[:, :, 0, :])[..., None] * s
             + jnp.einsum('bhsk,bhsv->bhkv', kc * jnp.exp(b_last - b), vc))
        return s, o

    s_final, o = lax.scan(step, s0, (blocks(q), blocks(k), blocks(v), blocks(log_f)))
    return o.transpose(1, 0, 3, 2, 4).reshape(bsz, t, h, dv), s_final


def hgrn2_mixer(xn, w_in, w_o, gnorm_w, lb, s0, chunk):
    bsz, t, _ = xn.shape
    q, f_raw, i, g = jnp.split(xn @ w_in, 4, axis=-1)
    heads = (bsz, t, A_HEADS, A_DK)
    q = jax.nn.silu(q.astype(jnp.float32)).reshape(heads)
    lb = lb.astype(jnp.float32)
    f = lb + (1.0 - lb) * jax.nn.sigmoid(f_raw.astype(jnp.float32))
    log_f = jnp.log(jnp.maximum(f, F_MIN)).reshape(heads)
    k = (1.0 - f).reshape(heads)
    v = i.astype(jnp.float32).reshape(bsz, t, A_HEADS, A_DV)
    o, s_new = hgrn2_chunk_scan(q, k, v, log_f, s0.astype(jnp.float32), chunk)
    gate = jax.nn.silu(g.astype(jnp.float32)).reshape(bsz, t, A_HEADS, A_DV)
    o = rms_norm(o, gnorm_w) * gate
    return o.reshape(bsz, t, D_MODEL).astype(xn.dtype) @ w_o, s_new


def swa_prompt(q, k, v, sinks, rel_bias):
    bsz, t = q.shape[:2]
    nb = t // WINDOW
    qb = q.reshape(bsz, nb, WINDOW, B_KV_HEADS, B_GROUPS, B_HEAD_DIM)

    def band(a):
        prev = jnp.pad(a, ((0, 0), (WINDOW, 0), (0, 0), (0, 0)))[:, :t]
        shp = (bsz, nb, WINDOW, B_KV_HEADS, B_HEAD_DIM)
        return jnp.concatenate([prev.reshape(shp), a.reshape(shp)], axis=2)

    kb, vb = band(k), band(v)
    scale = 1.0 / math.sqrt(B_HEAD_DIM)
    logits = jnp.einsum('bnqkgd,bnskd->bnkgqs', qb, kb).astype(jnp.float32) * scale
    t_loc = jnp.arange(WINDOW)[:, None]
    s_loc = jnp.arange(2 * WINDOW)[None, :]
    dist = t_loc + WINDOW - s_loc
    band_ok = (dist >= 0) & (dist < WINDOW)
    valid = band_ok[None] & ((jnp.arange(nb) > 0)[:, None, None] | (s_loc >= WINDOW)[None])
    logits = jnp.where(valid[None, :, None, None], logits + rel_bias_for(dist, rel_bias), MASK_VALUE)
    p = sink_softmax(logits, sinks)
    out = jnp.einsum('bnkgqs,bnskd->bnqkgd', p.astype(vb.dtype), vb)
    return out.reshape(bsz, t, B_HEADS * B_HEAD_DIM)


def swa_sample(q, k_buf, v_buf, k_new, v_new, sinks, rel_bias):
    bsz, s_len = q.shape[:2]
    w = k_buf.shape[1]
    kk = jnp.concatenate([k_buf, k_new.astype(k_buf.dtype)], axis=1)
    vv = jnp.concatenate([v_buf, v_new.astype(v_buf.dtype)], axis=1)
    qg = q.reshape(bsz, s_len, B_KV_HEADS, B_GROUPS, B_HEAD_DIM)
    scale = 1.0 / math.sqrt(B_HEAD_DIM)
    logits = jnp.einsum('bqkgd,bskd->bkgqs', qg, kk.astype(qg.dtype)).astype(jnp.float32) * scale
    dist = (w + jnp.arange(s_len))[:, None] - jnp.arange(w + s_len)[None, :]
    valid = (dist >= 0) & (dist < WINDOW)
    logits = jnp.where(valid, logits + rel_bias_for(dist, rel_bias), MASK_VALUE)
    p = sink_softmax(logits, sinks)
    out = jnp.einsum('bkgqs,bskd->bqkgd', p.astype(vv.dtype), vv)
    return out.reshape(bsz, s_len, B_HEADS * B_HEAD_DIM)


def trunk(x, c, hgrn_state0, k_buf, v_buf, w_in_a, w_o_a, gnorm_a, lb_a, w_kv, w_ada_kv, b_ada_kv,
          kv_norm_w, w_q_b, w_o_b, sinks_b, rel_bias, norm_w, w_ada, b_ada, w_ffn_in, w_ffn_out,
          final_norm_w):
    prompt = k_buf is None
    bsz, t, _ = x.shape
    lb_sm = jax.nn.softmax(lb_a.astype(jnp.float32), axis=0)
    lbs = jnp.cumsum(lb_sm, axis=0) - lb_sm[0:1]
    h = x
    new_states = []
    k_sh = v_sh = k_state = v_state = None
    for l in range(DEPTH):
        sh1, sc1, g1, sh2, sc2, g2 = jnp.split(ada_params(c, w_ada[l], b_ada[l]), 6, axis=-1)
        xn = modulate(h, norm_w[l, 0], sh1, sc1)
        if l < N_A_LAYERS:
            if prompt:
                s0 = jnp.zeros((bsz, A_HEADS, A_DK, A_DV), jnp.float32)
                chunk = A_CHUNK
            else:
                s0 = hgrn_state0[:, l]
                chunk = t
            mix, s_new = hgrn2_mixer(xn, w_in_a[l], w_o_a[l], gnorm_a[l], lbs[l], s0, chunk)
            new_states.append(s_new)
        else:
            j = l - N_A_LAYERS
            q = (xn @ w_q_b[j]).reshape(bsz, t, B_HEADS, B_HEAD_DIM)
            if prompt:
                att = swa_prompt(q, k_sh, v_sh, sinks_b[j], rel_bias)
            else:
                att = swa_sample(q, k_buf, v_buf, k_sh, v_sh, sinks_b[j], rel_bias)
            mix = att.astype(x.dtype) @ w_o_b[j]
        h = h + (g1[:, None, :] * mix.astype(jnp.float32)).astype(h.dtype)
        xn = modulate(h, norm_w[l, 1], sh2, sc2)
        h = h + (g2[:, None, :] * swiglu(xn, w_ffn_in[l], w_ffn_out[l]).astype(jnp.float32)).astype(h.dtype)
        if l == N_A_LAYERS - 1:
            sh_kv, sc_kv = jnp.split(ada_params(c, w_ada_kv, b_ada_kv), 2, axis=-1)
            kvn = modulate(h, kv_norm_w, sh_kv, sc_kv)
            k_sh, v_sh = jnp.split(kvn @ w_kv, 2, axis=-1)
            k_sh = k_sh.reshape(bsz, t, B_KV_HEADS, B_HEAD_DIM)
            v_sh = v_sh.reshape(bsz, t, B_KV_HEADS, B_HEAD_DIM)
            if prompt:
                k_state, v_state = k_sh[:, -WINDOW:], v_sh[:, -WINDOW:]
            else:
                k_state = jnp.concatenate([k_buf, k_sh.astype(k_buf.dtype)], axis=1)[:, -WINDOW:]
                v_state = jnp.concatenate([v_buf, v_sh.astype(v_buf.dtype)], axis=1)[:, -WINDOW:]
    y = rms_norm(h, final_norm_w).astype(x.dtype)
    return y, jnp.stack(new_states, axis=1).astype(x.dtype), k_state, v_state


def setup_inputs(seed: int = 0) -> dict:
    key = jax.random.key(seed)
    ks = jax.random.split(key, 25)
    D = D_MODEL
    f32 = jnp.float32

    def nrm(k, shape, scale):
        return jax.random.normal(k, shape, f32) * scale

    return {
        "x_prompt": nrm(ks[0], (BATCH, SEQ, D), 1.0),
        "x_sample": nrm(ks[1], (DEC_BATCH, DEC_SEQ, D), 1.0),
        "state_hgrn": nrm(ks[2], (DEC_BATCH, N_A_LAYERS, A_HEADS, A_DK, A_DV), 0.5),
        "cache_swa_k": nrm(ks[3], (DEC_BATCH, WINDOW, B_KV_HEADS, B_HEAD_DIM), 1.0),
        "cache_swa_v": nrm(ks[4], (DEC_BATCH, WINDOW, B_KV_HEADS, B_HEAD_DIM), 1.0),
        "c_prompt": nrm(ks[5], (BATCH, D), 1.0),
        "c_sample": nrm(ks[6], (DEC_BATCH, D), 1.0),
        "w_in_a": nrm(ks[7], (N_A_LAYERS, D, 4 * D), D ** -0.5),
        "w_o_a": nrm(ks[8], (N_A_LAYERS, D, D), D ** -0.5),
        "gnorm_a": 1.0 + nrm(ks[9], (N_A_LAYERS, A_DV), 0.02),
        "lb_a": nrm(ks[10], (N_A_LAYERS, D), 0.5),
        "w_kv": nrm(ks[11], (D, 2 * B_KV_HEADS * B_HEAD_DIM), D ** -0.5),
        "w_ada_kv": nrm(ks[12], (D, 2 * D), 0.5 * D ** -0.5),
        "b_ada_kv": nrm(ks[13], (2 * D,), 0.01),
        "kv_norm_w": 1.0 + nrm(ks[14], (D,), 0.02),
        "w_q_b": nrm(ks[15], (N_B_LAYERS, D, B_HEADS * B_HEAD_DIM), D ** -0.5),
        "w_o_b": nrm(ks[16], (N_B_LAYERS, B_HEADS * B_HEAD_DIM, D), (B_HEADS * B_HEAD_DIM) ** -0.5),
        "sinks_b": nrm(ks[17], (N_B_LAYERS, B_HEADS), 0.5),
        "rel_bias": nrm(ks[18], (N_BUCKETS, B_HEADS), 0.5),
        "norm_w": 1.0 + nrm(ks[19], (DEPTH, 2, D), 0.02),
        "w_ada": nrm(ks[20], (DEPTH, D, 6 * D), 0.5 * D ** -0.5),
        "b_ada": nrm(ks[21], (DEPTH, 6 * D), 0.01),
        "w_ffn_in": nrm(ks[22], (DEPTH, D, 2 * D_FF), D ** -0.5),
        "w_ffn_out": nrm(ks[23], (DEPTH, D_FF, D), D_FF ** -0.5),
        "final_norm_w": 1.0 + nrm(ks[24], (D,), 0.02),
    }


def reference(x_prompt, x_sample, state_hgrn, cache_swa_k, cache_swa_v, c_prompt, c_sample,
              w_in_a, w_o_a, gnorm_a, lb_a, w_kv, w_ada_kv, b_ada_kv, kv_norm_w, w_q_b, w_o_b,
              sinks_b, rel_bias, norm_w, w_ada, b_ada, w_ffn_in, w_ffn_out, final_norm_w):
    weights = (w_in_a, w_o_a, gnorm_a, lb_a, w_kv, w_ada_kv, b_ada_kv, kv_norm_w, w_q_b, w_o_b,
               sinks_b, rel_bias, norm_w, w_ada, b_ada, w_ffn_in, w_ffn_out, final_norm_w)
    y_prompt, state_hgrn_prompt, cache_swa_k_prompt, cache_swa_v_prompt = trunk(
        x_prompt, c_prompt, None, None, None, *weights)
    y_sample, state_hgrn_sample, cache_swa_k_sample, cache_swa_v_sample = trunk(
        x_sample, c_sample, state_hgrn, cache_swa_k, cache_swa_v, *weights)
    return (y_prompt, y_sample, state_hgrn_prompt, state_hgrn_sample,
            cache_swa_k_prompt, cache_swa_v_prompt, cache_swa_k_sample, cache_swa_v_sample)
```

```cpp
#include <hip/hip_runtime.h>
#include <cstdio>
#include <cstdint>
#define GAS __attribute__((address_space(1)))
#define LAS __attribute__((address_space(3)))
namespace pg8 {
#define PG8_LAS __attribute__((address_space(3)))
typedef unsigned short bf16_t;
typedef short bf16x8 __attribute__((ext_vector_type(8)));
typedef float f32x4 __attribute__((ext_vector_type(4)));
typedef unsigned u32x4 __attribute__((ext_vector_type(4)));
constexpr int BM = 256, BK = 64, HALF = 128, HTB = HALF * BK * 2  , STAGE_BYTES = 8 * HTB, NXCD = 8, WGM = 8;

__host__ __device__ __forceinline__ int lds_byte(int r, int c) { const int st = (r >> 4) * 2 + (c >> 5), rr = r & 15, cc = c & 31, ob = rr * 64 + cc * 2; return st * 1024 + (ob ^ (((ob >> 9) & 1) << 5)); }
__host__ __device__ __forceinline__ void stage_rc(int b, int& R, int& C) { const int st = b / 1024, sb = b % 1024, swz = sb ^ (((sb >> 9) & 1) << 5); R = (st >> 1) * 16 + swz / 64; C = (st & 1) * 32 + (swz % 64) / 2; }
__host__ __device__ __forceinline__ int perm32(int rho) { const int n = rho >> 4, i = rho & 15; return 8 * (i >> 2) + 4 * n + (i & 3); }

struct Unit { int pm, pn; };
struct Gemm { const GAS bf16_t* A; const GAS bf16_t* Bt; int M, N, K; };

struct StaticOrder {
    int nM, nN, nwg, G, c;
    __host__ __device__ void init(int M, int N, int G_, int c_) { nM = M / BM; nN = N / BM; nwg = nM * nN; G = G_; c = c_; }
    __host__ __device__ bool next(int i, Unit& u) const {
        const long L = (long)i * G + c; if (L >= nwg) return false;
        int wgid = (int)L; { const int q = nwg / NXCD, r = nwg % NXCD, xcd = wgid % NXCD, off = wgid / NXCD; wgid = (xcd < r ? xcd * (q + 1) : r * (q + 1) + (xcd - r) * q) + off; }
        const int nig = WGM * nN, gid = wgid / nig, fm = gid * WGM, gsz = (nM - fm) < WGM ? (nM - fm) : WGM;
        u.pm = fm + ((wgid % nig) % gsz); u.pn = (wgid % nig) / gsz; return true;
    }
    __device__ __forceinline__ void a_ready(const Unit&) const {}
    __device__ __forceinline__ void done(const Unit&) const {}
};

template <class Epi, class Sched, bool ALIGN_EPI = false, bool SP2 = false>
__device__ __forceinline__ void gemm_phase(PG8_LAS unsigned char* lds, const Gemm g, const Sched& S, const Epi& E, const int tid_in) {
    const int tid = tid_in, wid = __builtin_amdgcn_readfirstlane(tid >> 6), lane = tid & 63, wr = wid >> 2, wc = wid & 3, fr = lane & 15, fq = lane >> 4;
    const int K = g.K, nt = K / BK;
    unsigned voffA[2], voffB[2];
#pragma unroll
    for (int i = 0; i < 2; ++i) { int R, C; stage_rc(tid * 16 + i * 8192, R, C); const int Rb = Epi::PERM ? ((R & ~31) + perm32(R & 31)) : R;
        voffA[i] = (unsigned)(R * K + C) * 2u; voffB[i] = (unsigned)(Rb * K + C) * 2u; }
    const size_t kstep = (size_t)(BK * 2);
    const size_t hstep = (size_t)HALF * K * 2;
    const size_t tstep = 2 * hstep;
    const unsigned ldsw = (unsigned)wid * 1024u;
    const int aoff = lds_byte(wr * 64 + fr, fq * 8), boff = lds_byte(wc * 32 + fr, fq * 8);
#define PG8_SA(b, h) (((b) * 2 + (h)) * HTB)
#define PG8_SB(b, h) ((4 + (b) * 2 + (h)) * HTB)
#define PG8_STAGE(bufoff, gbase, voff) do { _Pragma("unroll") for (int _i = 0; _i < 2; ++_i) \
        __builtin_amdgcn_global_load_lds((const GAS unsigned*)((const GAS char*)(gbase) + (voff)[_i]), (PG8_LAS unsigned*)(lds + (bufoff) + ldsw + _i * 8192), 16, 0, 0); } while (0)
#define PG8_LDA(dst, b, h) do { _Pragma("unroll") for (int m = 0; m < 4; ++m) _Pragma("unroll") for (int k = 0; k < 2; ++k) dst[m][k] = *(const PG8_LAS bf16x8*)(lds + PG8_SA(b, h) + aoff + m * 2048 + k * 1024); } while (0)
#define PG8_LDB(dst, b, h) do { _Pragma("unroll") for (int n = 0; n < 2; ++n) _Pragma("unroll") for (int k = 0; k < 2; ++k) dst[n][k] = *(const PG8_LAS bf16x8*)(lds + PG8_SB(b, h) + boff + n * 2048 + k * 1024); } while (0)
#define PG8_MMA(ai, bj, At, Bt) do { __builtin_amdgcn_s_setprio(1); _Pragma("unroll") for (int m = 0; m < 4; ++m) _Pragma("unroll") for (int n = 0; n < 2; ++n) _Pragma("unroll") for (int k = 0; k < 2; ++k) \
        acc[ai][bj][m][n] = __builtin_amdgcn_mfma_f32_16x16x32_bf16(Bt[n][k], At[m][k], acc[ai][bj][m][n], 0, 0, 0); __builtin_amdgcn_s_setprio(0); } while (0)
#define PG8_WAIT_V(n) asm volatile("s_waitcnt vmcnt(" #n ")" ::: "memory")
#define PG8_WAIT_L(n) asm volatile("s_waitcnt lgkmcnt(" #n ")" ::: "memory")
#define PG8_BAR __builtin_amdgcn_s_barrier()
#define PG8_SCHED __builtin_amdgcn_sched_barrier(0)
    Unit cur, nxt; int ui = 0;
    if (!S.next(0, cur)) return;
    f32x4 acc[2][2][4][2];
#pragma unroll
    for (int a = 0; a < 2; ++a)
#pragma unroll
        for (int b = 0; b < 2; ++b)
#pragma unroll
            for (int m = 0; m < 4; ++m)
#pragma unroll
                for (int n = 0; n < 2; ++n) acc[a][b][m][n] = (f32x4){0.f, 0.f, 0.f, 0.f};
    bf16x8 At[4][2], B0[2][2], B1[2][2];
    const GAS char* cA = (const GAS char*)g.A + (size_t)cur.pm * tstep; const GAS char* cB = (const GAS char*)g.Bt + (size_t)cur.pn * tstep;
    S.a_ready(cur);
    if constexpr (SP2) {
        PG8_STAGE(PG8_SB(0, 0), cB, voffB); PG8_STAGE(PG8_SB(0, 1), cB + hstep, voffB); PG8_STAGE(PG8_SA(0, 0), cA, voffA); PG8_STAGE(PG8_SA(0, 1), cA + hstep, voffA);
        if (wr == 1) PG8_BAR;
        PG8_WAIT_V(2); PG8_BAR;
        PG8_STAGE(PG8_SB(1, 0), cB + kstep, voffB); PG8_STAGE(PG8_SA(1, 0), cA + kstep, voffA); PG8_STAGE(PG8_SB(1, 1), cB + hstep + kstep, voffB);
        PG8_WAIT_V(6); PG8_BAR;
    } else {
        PG8_STAGE(PG8_SB(0, 0), cB, voffB); PG8_STAGE(PG8_SA(0, 0), cA, voffA); PG8_STAGE(PG8_SB(0, 1), cB + hstep, voffB); PG8_STAGE(PG8_SA(0, 1), cA + hstep, voffA);
        if (wr == 1) PG8_BAR;
        PG8_WAIT_V(4); PG8_BAR;
        PG8_STAGE(PG8_SB(1, 0), cB + kstep, voffB); PG8_STAGE(PG8_SA(1, 0), cA + kstep, voffA); PG8_STAGE(PG8_SB(1, 1), cB + hstep + kstep, voffB);
        PG8_WAIT_V(6); PG8_BAR;
    }
    for (;;) {
        const bool has_next = S.next(ui + 1, nxt);
        const GAS char* nA = has_next ? (const GAS char*)g.A + (size_t)nxt.pm * tstep : cA; const GAS char* nB = has_next ? (const GAS char*)g.Bt + (size_t)nxt.pn * tstep : cB;
        for (int t = 0; t < nt; t += 2) {
            const bool last = (t == nt - 2);
            const GAS char* a1 = cA + (size_t)(t + 1) * kstep;
            const GAS char* a2 = last ? nA : cA + (size_t)(t + 2) * kstep; const GAS char* b2 = last ? nB : cB + (size_t)(t + 2) * kstep;
            const GAS char* a3 = a2 + kstep; const GAS char* b3 = b2 + kstep;
            if (last && has_next) S.a_ready(nxt);
            if constexpr (SP2) {
            PG8_LDB(B0, 0, 0); PG8_LDB(B1, 0, 1); PG8_SCHED; PG8_LDA(At, 0, 0); PG8_STAGE(PG8_SA(1, 1), a1 + hstep, voffA);
            PG8_WAIT_V(8); PG8_WAIT_L(0); PG8_BAR; PG8_MMA(0, 0, At, B0); PG8_MMA(0, 1, At, B1); PG8_BAR; PG8_SCHED;
            PG8_LDA(At, 0, 1); PG8_STAGE(PG8_SB(0, 0), b2, voffB); PG8_STAGE(PG8_SB(0, 1), b2 + hstep, voffB); PG8_STAGE(PG8_SA(0, 0), a2, voffA);
            PG8_WAIT_V(8); PG8_WAIT_L(0); PG8_BAR; PG8_MMA(1, 0, At, B0); PG8_MMA(1, 1, At, B1); PG8_BAR; PG8_SCHED;
            PG8_LDB(B0, 1, 0); PG8_LDB(B1, 1, 1); PG8_SCHED; PG8_LDA(At, 1, 0); PG8_STAGE(PG8_SA(0, 1), a2 + hstep, voffA);
            PG8_WAIT_V(8); PG8_WAIT_L(0); PG8_BAR; PG8_MMA(0, 0, At, B0); PG8_MMA(0, 1, At, B1); PG8_BAR; PG8_SCHED;
            PG8_LDA(At, 1, 1); PG8_STAGE(PG8_SB(1, 0), b3, voffB); PG8_STAGE(PG8_SB(1, 1), b3 + hstep, voffB); PG8_STAGE(PG8_SA(1, 0), a3, voffA);
            PG8_WAIT_V(8); PG8_WAIT_L(0); PG8_BAR; PG8_MMA(1, 0, At, B0); PG8_MMA(1, 1, At, B1); PG8_BAR; PG8_SCHED;
            } else {
            PG8_LDB(B0, 0, 0); PG8_SCHED; PG8_LDA(At, 0, 0); PG8_STAGE(PG8_SA(1, 1), a1 + hstep, voffA);
            PG8_WAIT_L(8); PG8_BAR; PG8_WAIT_L(0); PG8_MMA(0, 0, At, B0); PG8_BAR; PG8_SCHED;
            PG8_LDB(B1, 0, 1); PG8_STAGE(PG8_SB(0, 0), b2, voffB);
            PG8_BAR; PG8_WAIT_L(0); PG8_MMA(0, 1, At, B1); PG8_BAR;
            PG8_LDA(At, 0, 1); PG8_STAGE(PG8_SA(0, 0), a2, voffA);
            PG8_BAR; PG8_WAIT_L(0); PG8_MMA(1, 0, At, B0); PG8_BAR; PG8_SCHED;
            PG8_STAGE(PG8_SB(0, 1), b2 + hstep, voffB);
            PG8_WAIT_V(6); PG8_BAR; PG8_MMA(1, 1, At, B1); PG8_BAR;
            PG8_LDB(B0, 1, 0); PG8_SCHED; PG8_LDA(At, 1, 0); PG8_STAGE(PG8_SA(0, 1), a2 + hstep, voffA);
            PG8_WAIT_L(8); PG8_BAR; PG8_WAIT_L(0); PG8_MMA(0, 0, At, B0); PG8_BAR; PG8_SCHED;
            PG8_LDB(B1, 1, 1); PG8_STAGE(PG8_SB(1, 0), b3, voffB);
            PG8_BAR; PG8_WAIT_L(0); PG8_MMA(0, 1, At, B1); PG8_BAR;
            PG8_LDA(At, 1, 1); PG8_STAGE(PG8_SA(1, 0), a3, voffA);
            PG8_BAR; PG8_WAIT_L(0); PG8_MMA(1, 0, At, B0); PG8_BAR; PG8_SCHED;
            PG8_STAGE(PG8_SB(1, 1), b3 + hstep, voffB);
            PG8_WAIT_V(6); PG8_BAR; PG8_MMA(1, 1, At, B1); PG8_BAR;
            }
        }
        if constexpr (ALIGN_EPI) { if (wr == 0) PG8_BAR; }
        if constexpr (!Epi::AFTER_DRAIN) { E(acc, cur, wr, wc, fr, fq); S.done(cur); }
        if (!has_next) break;
#pragma unroll
        for (int a = 0; a < 2; ++a)
#pragma unroll
            for (int b = 0; b < 2; ++b)
#pragma unroll
                for (int m = 0; m < 4; ++m)
#pragma unroll
                    for (int n = 0; n < 2; ++n) acc[a][b][m][n] = (f32x4){0.f, 0.f, 0.f, 0.f};
        cur = nxt; cA = nA; cB = nB; ++ui;
        if constexpr (ALIGN_EPI) { if (wr == 1) PG8_BAR; }
    }
    PG8_WAIT_V(0);
    if constexpr (!ALIGN_EPI) { if (wr == 0) PG8_BAR; }
    PG8_BAR;
    if constexpr (Epi::AFTER_DRAIN) { E.fused(acc, cur, wr, wc, fr, fq, lds, wid, lane); S.done(cur); }
#undef PG8_SA
#undef PG8_SB
#undef PG8_STAGE
#undef PG8_LDA
#undef PG8_LDB
#undef PG8_MMA
#undef PG8_WAIT_V
#undef PG8_WAIT_L
#undef PG8_BAR
#undef PG8_SCHED
}
}


typedef unsigned short bf16;
typedef unsigned v4u __attribute__((ext_vector_type(4)));
typedef float f32x4 __attribute__((ext_vector_type(4)));
typedef short bf16x8 __attribute__((ext_vector_type(8)));
typedef GAS unsigned gu32;
typedef GAS unsigned long long gu64;
#define RLX_AGENT __ATOMIC_RELAXED, __HIP_MEMORY_SCOPE_AGENT
#define LDS_WAIT() asm volatile("s_waitcnt lgkmcnt(0)" ::: "memory")
#define VM_WAIT() asm volatile("s_waitcnt vmcnt(0)" ::: "memory")
__device__ __forceinline__ unsigned long long rt() { return __builtin_amdgcn_s_memrealtime(); }
__device__ __forceinline__ unsigned f2bf(float f) { unsigned u = __builtin_bit_cast(unsigned, f); return (u + 0x7fffu + ((u >> 16) & 1u)) >> 16; }
__device__ __forceinline__ unsigned pk2(float lo, float hi) { return f2bf(lo) | (f2bf(hi) << 16); }

#define XB_TMO      128
#define XB_XCNT(j)  (256  + 64 * (j))
#define XB_XSUB(j)  (1280 + 64 * (j))
#define XB_XGEN(j)  (2304 + 64 * (j))
#define XB_TOP      3328
#define XB_TOPGEN   3392
#define XCD_BAR_WORDS 3456
#define XB_SPIN_CAP (1u << 18)

__device__ __forceinline__ unsigned xb_ld(unsigned* p)              { return __hip_atomic_load(p, __ATOMIC_RELAXED, __HIP_MEMORY_SCOPE_AGENT); }
__device__ __forceinline__ unsigned xb_add(unsigned* p, unsigned v) { return __hip_atomic_fetch_add(p, v, __ATOMIC_RELAXED, __HIP_MEMORY_SCOPE_AGENT); }
__device__ __forceinline__ unsigned xb_xcc_id() { return (unsigned)__builtin_amdgcn_s_getreg((3 << 11) | 20) & 0xFu; }
#define XB_SPIN(cond, bar) do { unsigned _sp = 0; while (cond) { __builtin_amdgcn_s_sleep(1); \
    if ((++_sp & 255u) == 0u) { if (xb_ld(&(bar)[XB_TMO])) break; if (_sp > XB_SPIN_CAP) { atomicAdd(&(bar)[XB_TMO], 1u); break; } } } } while (0)

struct XcdBarrier {
    unsigned* bar; unsigned x;
    volatile LAS unsigned* st;
};

__device__ __forceinline__ XcdBarrier xcd_barrier_post(unsigned* bar, volatile LAS unsigned* st) {
    XcdBarrier b; b.bar = bar; b.x = xb_xcc_id(); b.st = st;
    if (threadIdx.x == 0) (void)xb_add(&bar[XB_XCNT(b.x)], 1u);
    return b;
}
__device__ __forceinline__ void xcd_barrier_complete(unsigned* bar, unsigned x, unsigned& nloc, unsigned& nx) {
    const unsigned G = gridDim.x * gridDim.y * gridDim.z;
    unsigned sum, cnt, mine, sp = 0u;
    for (;;) {
        sum = 0u; cnt = 0u; mine = 0u;
#pragma unroll
        for (unsigned j = 0; j < 16; ++j) { const unsigned c = xb_ld(&bar[XB_XCNT(j)]); sum += c; cnt += (c > 0u) ? 1u : 0u; mine = (j == x) ? c : mine; }
        if (sum == G) break;
        __builtin_amdgcn_s_sleep(1);
        if ((++sp & 255u) == 0u) { if (xb_ld(&bar[XB_TMO])) break; if (sp > XB_SPIN_CAP) { atomicAdd(&bar[XB_TMO], 1u); break; } }
    }
    nloc = mine > 0u ? mine : 1u; nx = cnt > 0u ? cnt : 1u;
}

__device__ __forceinline__ void xcd_barrier(const XcdBarrier& b) {
    asm volatile("s_waitcnt vmcnt(0)" ::: "memory");
    __syncthreads();
    if (threadIdx.x == 0) {
        unsigned* bar = b.bar;
        __builtin_amdgcn_s_waitcnt(0);
        unsigned nloc = b.st[0], nx = b.st[1];
        if (nloc == 0u) { xcd_barrier_complete(bar, b.x, nloc, nx); b.st[0] = nloc; b.st[1] = nx; }
        const unsigned old = xb_add(&bar[XB_XSUB(b.x)], 1u);
        const unsigned gen = old / nloc;
        if (old + 1u == (gen + 1u) * nloc) {
            __builtin_amdgcn_fence(__ATOMIC_RELEASE, "agent");
            asm volatile("s_waitcnt vmcnt(0)" ::: "memory");
            const unsigned og = xb_add(&bar[XB_TOP], 1u);
            const unsigned tg = og / nx;
            if (og + 1u == (tg + 1u) * nx) xb_add(&bar[XB_TOPGEN], 1u);
            else XB_SPIN(xb_ld(&bar[XB_TOPGEN]) == tg, bar);
            __builtin_amdgcn_fence(__ATOMIC_ACQUIRE, "agent");
            xb_add(&bar[XB_XGEN(b.x)], 1u);
            asm volatile("s_waitcnt vmcnt(0)" ::: "memory");
        } else {
            XB_SPIN(xb_ld(&bar[XB_XGEN(b.x)]) == gen, bar);
            __builtin_amdgcn_fence(__ATOMIC_ACQUIRE, "agent");
            asm volatile("s_waitcnt vmcnt(0)" ::: "memory");
        }
    }
    __syncthreads();
}
typedef pg8::u32x4 u32x4;
typedef unsigned u32x2 __attribute__((ext_vector_type(2)));
constexpr int D = 1024, SEQ = 8192, MP = 16384, MS = 128, MT = MP + MS, MPAD = 16640;
constexpr int DFF = 2816, NFF2 = 2 * DFF, NCOND = 130, ADAW = 6 * D;
constexpr float EPSF = 1e-6f;
constexpr size_t OY_P = 0, OY_S = 16777216, OST_P = 16908288, OST_S = 17432576, OCK_P = 50987008, OCV_P = 51052544, OCK_S = 51118080, OCV_S = 55312384, OUT_TOTAL = 59506688;

__device__ __forceinline__ unsigned cvt_pk(float lo, float hi) { unsigned r; asm volatile("v_cvt_pk_bf16_f32 %0, %1, %2" : "=v"(r) : "v"(lo), "v"(hi)); return r; }
__device__ __forceinline__ float bf2f(unsigned short u) { return __uint_as_float((unsigned)u << 16); }
__device__ __forceinline__ float silu_f(float x) { return x / (1.0f + __expf(-x)); }
__device__ __forceinline__ float sigmoid_f(float x) { return 1.0f / (1.0f + __expf(-x)); }
__device__ __forceinline__ int cond_of(int row) { return row < MP ? 128 + (row >> 13) : ((row - MP) < MS ? (row - MP) : MS - 1); }

constexpr size_t MiB = 1u << 20;
constexpr size_t WS_CTL = 0, CTL_ZERO_BYTES = 1 * MiB;
constexpr size_t WS_WIN = 1 * MiB, WS_WOA = 17 * MiB, WS_WKV = 21 * MiB, WS_WQ = 22 * MiB, WS_WOB = 26 * MiB, WS_WF1 = 30 * MiB, WS_WF2 = 74 * MiB;
constexpr size_t WS_ADA = 96 * MiB, WS_ADAKV = 109 * MiB;
constexpr size_t WS_SCAN = 111 * MiB, WS_DLOG = 127 * MiB;
constexpr size_t WS_H = 128 * MiB;
constexpr size_t WS_XN = 193 * MiB, WS_OG = 226 * MiB;
constexpr size_t WS_KSH = 259 * MiB, WS_VSH = 268 * MiB;
constexpr size_t WS_QH = 277 * MiB, WS_LF = 310 * MiB, WS_VH = 375 * MiB, WS_GH = 408 * MiB;
constexpr size_t WS_ACT = 277 * MiB;
constexpr size_t WS_XNKV = 408 * MiB;
constexpr size_t WS_END = 441 * MiB;
static_assert(WS_ACT + (size_t)MPAD * DFF * 2 <= WS_VH && WS_H + (size_t)MPAD * D * 4 <= WS_XN && WS_ADA + (size_t)4 * NCOND * ADAW * 4 <= WS_ADAKV, "d_ws map");
constexpr int CW_BAR = 4096;
constexpr int WIN_SZ = 4096 * 1024, WOA_SZ = 1024 * 1024, WF1_SZ = NFF2 * 1024, WF2_SZ = 1024 * DFF;
constexpr int RING_OFF = 0, RING_BYTES = 131072, LDSCTL_OFF = RING_BYTES, MISC_OFF = LDSCTL_OFF + 320, LDS_BYTES = 147456;
constexpr int NWAVES = 8;
#define EPI_LOOP_BEGIN \
    _Pragma("unroll") for (int ai = 0; ai < 2; ++ai) _Pragma("unroll") for (int m = 0; m < 4; ++m) { const int row = u.pm * 256 + ai * 128 + wr * 64 + m * 16 + fr; \
    _Pragma("unroll") for (int bj = 0; bj < 2; ++bj) { const int ct = bj * 128 + wc * 32 + 8 * fq; const f32x4 v0 = acc[ai][bj][m][0], v1 = acc[ai][bj][m][1];
#define EPI_LOOP_END } }

struct EpiInProj {
    static constexpr bool PERM = true, AFTER_DRAIN = false;
    GAS unsigned char* ws; const GAS float* lb0; const GAS float* lb1; int layer;
    __device__ __forceinline__ void operator()(const f32x4 (&acc)[2][2][4][2], const pg8::Unit& u, int wr, int wc, int fr, int fq) const {
        const int kind = u.pn >> 2, cb = (u.pn & 3) * 256;
        EPI_LOOP_BEGIN
            const int c = cb + ct; const size_t off = (size_t)row * D + c;
            if (kind == 1) {
                f32x4 o0, o1;
#pragma unroll
                for (int j = 0; j < 4; ++j) {
                    float lba = 0.f, lbb = 0.f;
                    if (layer == 1) { lba = sigmoid_f(lb1[c + j] - lb0[c + j]); lbb = sigmoid_f(lb1[c + 4 + j] - lb0[c + 4 + j]); }
                    const float fa = lba + (1.0f - lba) * sigmoid_f(v0[j]), fb = lbb + (1.0f - lbb) * sigmoid_f(v1[j]);
                    o0[j] = logf(fmaxf(fa, 1e-30f)); o1[j] = logf(fmaxf(fb, 1e-30f));
                }
                GAS float* LF = (GAS float*)(ws + WS_LF); *(GAS f32x4*)(LF + off) = o0; *(GAS f32x4*)(LF + off + 4) = o1;
            } else {
                f32x4 a = v0, b = v1;
                if (kind != 2) {
#pragma unroll
                    for (int j = 0; j < 4; ++j) { a[j] = silu_f(a[j]); b[j] = silu_f(b[j]); }
                }
                u32x4 w; w.x = cvt_pk(a[0], a[1]); w.y = cvt_pk(a[2], a[3]); w.z = cvt_pk(b[0], b[1]); w.w = cvt_pk(b[2], b[3]);
                const size_t ob = kind == 0 ? WS_QH : (kind == 2 ? WS_VH : WS_GH); GAS bf16* dst = (GAS bf16*)(ws + ob);
                *(GAS u32x4*)(dst + off) = w;
            }
        EPI_LOOP_END
    }
};
struct EpiRes {
    static constexpr bool PERM = true, AFTER_DRAIN = false;
    GAS float* H; const GAS float* gate;
    __device__ __forceinline__ void operator()(const f32x4 (&acc)[2][2][4][2], const pg8::Unit& u, int wr, int wc, int fr, int fq) const {
        EPI_LOOP_BEGIN
            const int c = u.pn * 256 + ct; const size_t off = (size_t)row * D + c;
            const GAS float* gp = gate + (size_t)cond_of(row) * ADAW + c;
            const f32x4 g0 = *(const GAS f32x4*)gp, g1 = *(const GAS f32x4*)(gp + 4);
            const f32x4 h0 = *(const GAS f32x4*)(H + off), h1 = *(const GAS f32x4*)(H + off + 4);
            *(GAS f32x4*)(H + off) = h0 + g0 * v0; *(GAS f32x4*)(H + off + 4) = h1 + g1 * v1;
        EPI_LOOP_END
    }
};
struct EpiSwiGLU {
    static constexpr bool PERM = true, AFTER_DRAIN = false;
    GAS bf16* ACT;
    __device__ __forceinline__ void operator()(const f32x4 (&acc)[2][2][4][2], const pg8::Unit& u, int wr, int wc, int fr, int fq) const {
        EPI_LOOP_BEGIN
            const int oc = (u.pn * 256 + ct) >> 1;
            u32x2 w; w.x = cvt_pk(silu_f(v0[0]) * v1[0], silu_f(v0[1]) * v1[1]); w.y = cvt_pk(silu_f(v0[2]) * v1[2], silu_f(v0[3]) * v1[3]);
            *(GAS u32x2*)(ACT + (size_t)row * DFF + oc) = w;
        EPI_LOOP_END
    }
};
struct EpiKV {
    static constexpr bool PERM = true, AFTER_DRAIN = false;
    GAS bf16* KSH; GAS bf16* VSH; GAS float* out;
    __device__ __forceinline__ void operator()(const f32x4 (&acc)[2][2][4][2], const pg8::Unit& u, int wr, int wc, int fr, int fq) const {
        GAS bf16* dst = u.pn == 0 ? KSH : VSH;
        EPI_LOOP_BEGIN
            const int c = ct;
            u32x4 w; w.x = cvt_pk(v0[0], v0[1]); w.y = cvt_pk(v0[2], v0[3]); w.z = cvt_pk(v1[0], v1[1]); w.w = cvt_pk(v1[2], v1[3]);
            *(GAS u32x4*)(dst + (size_t)row * 256 + c) = w;
            GAS float* o = nullptr;
            if (row < MP) { const int t = row & (SEQ - 1), b = row >> 13; if (t >= SEQ - 128) o = out + (u.pn == 0 ? OCK_P : OCV_P) + ((size_t)(b * 128 + (t - (SEQ - 128))) * 256 + c); }
            else if (row < MT) { o = out + (u.pn == 0 ? OCK_S : OCV_S) + ((size_t)((row - MP) * 128 + 127) * 256 + c); }
            if (o) { *(GAS f32x4*)o = v0; *(GAS f32x4*)(o + 4) = v1; }
        EPI_LOOP_END
    }
};
struct EpiQ {
    static constexpr bool PERM = true, AFTER_DRAIN = false;
    GAS bf16* Q;
    __device__ __forceinline__ void operator()(const f32x4 (&acc)[2][2][4][2], const pg8::Unit& u, int wr, int wc, int fr, int fq) const {
        EPI_LOOP_BEGIN
            const int c = u.pn * 256 + ct;
            u32x4 w; w.x = cvt_pk(v0[0] * 0.125f, v0[1] * 0.125f); w.y = cvt_pk(v0[2] * 0.125f, v0[3] * 0.125f); w.z = cvt_pk(v1[0] * 0.125f, v1[1] * 0.125f); w.w = cvt_pk(v1[2] * 0.125f, v1[3] * 0.125f);
            *(GAS u32x4*)(Q + (size_t)row * D + c) = w;
        EPI_LOOP_END
    }
};
struct Args { const GAS float* in[25]; GAS float* out; GAS unsigned char* ws; };
constexpr int PTAB_OFF = LDSCTL_OFF + 1024;
__device__ __forceinline__ unsigned long long ldptr(volatile LAS unsigned long long* tab, int i) {
    const unsigned long long v = tab[i];
    const unsigned lo = __builtin_amdgcn_readfirstlane((unsigned)v), hi = __builtin_amdgcn_readfirstlane((unsigned)(v >> 32));
    return ((unsigned long long)hi << 32) | lo;
}
#define PTF(i) ((const GAS float*)ldptr(PT, (i)))
enum { I_XP = 0, I_XS, I_STATE, I_CK, I_CV, I_CP, I_CS, I_WIN, I_WOA, I_GNORM, I_LB, I_WKV, I_WADAKV, I_BADAKV, I_KVNORM, I_WQ, I_WOB, I_SINKS, I_RELB, I_NORMW, I_WADA, I_BADA, I_WF1, I_WF2, I_FNORM };

__device__ __forceinline__ float wave_sum(float v) {
#pragma unroll
    for (int o = 1; o < 64; o <<= 1) v += __shfl_xor(v, o);
    return v;
}
__device__ __forceinline__ float wave_max(float v) {
#pragma unroll
    for (int o = 1; o < 64; o <<= 1) v = fmaxf(v, __shfl_xor(v, o));
    return v;
}
__device__ __forceinline__ void transpose_item(const GAS float* W, int K, int N, GAS bf16* WT, int mode, LAS float* scr, int item, int lane) {
    const int nblk = N / 32, kb = item / nblk, nb = item % nblk, k0 = 64 * kb, n0 = 32 * nb;
#pragma unroll 8
    for (int i = 0; i < 32; ++i) { const int kk = 2 * i + (lane >> 5); scr[kk * 33 + (lane & 31)] = W[(size_t)(k0 + kk) * N + n0 + (lane & 31)]; }
    LDS_WAIT(); asm volatile("" ::: "memory");
    const int c = lane & 7;
#pragma unroll
    for (int j = 0; j < 4; ++j) { const int n = (lane >> 3) + 8 * j; const LAS float* s = scr + (8 * c) * 33 + n;
        v4u o; o.x = pk2(s[0 * 33], s[1 * 33]); o.y = pk2(s[2 * 33], s[3 * 33]); o.z = pk2(s[4 * 33], s[5 * 33]); o.w = pk2(s[6 * 33], s[7 * 33]);
        const int gn = n0 + n; int drow = gn;
        if (mode == 1) { const int up = gn >= DFF ? 1 : 0; const int jn = up ? gn - DFF : gn; drow = 8 * (jn >> 2) + (jn & 3) + 4 * up; }
        *(GAS v4u*)(WT + (size_t)drow * K + k0 + 8 * c) = o; }
    LDS_WAIT(); asm volatile("" ::: "memory");
}
__device__ __forceinline__ void p0_transposes(volatile LAS unsigned long long* PT, LAS unsigned char* lds, int gw, int NGW, int wave, int lane) {
    LAS float* scr = (LAS float*)(lds + RING_OFF + 16384 + wave * 12288);
    GAS unsigned char* ws = (GAS unsigned char*)ldptr(PT, 26);
    constexpr int I_IN = 16 * 128, I_SQ = 16 * 32, I_KV = 16 * 16, I_F1 = 16 * (NFF2 / 32), I_F2 = (DFF / 64) * 32;
    constexpr int TOTAL = 2 * I_IN + 2 * I_SQ + I_KV + 2 * I_SQ + 2 * I_SQ + 4 * I_F1 + 4 * I_F2;
    for (int it = gw; it < TOTAL; it += NGW) {
        int r = it; const GAS float* W; GAS bf16* WT; int K = D, N = D, mode = 0, item;
        if (r < 4 * I_F1) { const int l = r / I_F1; W = PTF(I_WF1) + (size_t)l * D * NFF2; N = NFF2; WT = (GAS bf16*)(ws + WS_WF1) + (size_t)l * WF1_SZ; mode = 1; item = r % I_F1; }
        else if ((r -= 4 * I_F1) < 4 * I_F2) { const int l = r / I_F2; W = PTF(I_WF2) + (size_t)l * DFF * D; K = DFF; WT = (GAS bf16*)(ws + WS_WF2) + (size_t)l * WF2_SZ; item = r % I_F2; }
        else if ((r -= 4 * I_F2) < 2 * I_IN) { const int l = r / I_IN; W = PTF(I_WIN) + (size_t)l * D * 4096; N = 4096; WT = (GAS bf16*)(ws + WS_WIN) + (size_t)l * WIN_SZ; item = r % I_IN; }
        else if ((r -= 2 * I_IN) < 2 * I_SQ) { const int l = r / I_SQ; W = PTF(I_WOA) + (size_t)l * D * D; WT = (GAS bf16*)(ws + WS_WOA) + (size_t)l * WOA_SZ; item = r % I_SQ; }
        else if ((r -= 2 * I_SQ) < 2 * I_SQ) { const int l = r / I_SQ; W = PTF(I_WQ) + (size_t)l * D * D; WT = (GAS bf16*)(ws + WS_WQ) + (size_t)l * WOA_SZ; item = r % I_SQ; }
        else if ((r -= 2 * I_SQ) < 2 * I_SQ) { const int l = r / I_SQ; W = PTF(I_WOB) + (size_t)l * D * D; WT = (GAS bf16*)(ws + WS_WOB) + (size_t)l * WOA_SZ; item = r % I_SQ; }
        else { r -= 2 * I_SQ; W = PTF(I_WKV); N = 512; WT = (GAS bf16*)(ws + WS_WKV); item = r; }
        transpose_item(W, K, N, WT, mode, scr, item, lane);
    }
}
__device__ __forceinline__ bf16x8 silu8_bf16(const GAS float* p) {
    const f32x4 x0 = *(const GAS f32x4*)p, x1 = *(const GAS f32x4*)(p + 4);
    u32x4 w; w.x = cvt_pk(silu_f(x0[0]), silu_f(x0[1])); w.y = cvt_pk(silu_f(x0[2]), silu_f(x0[3])); w.z = cvt_pk(silu_f(x1[0]), silu_f(x1[1])); w.w = cvt_pk(silu_f(x1[2]), silu_f(x1[3]));
    return __builtin_bit_cast(bf16x8, w);
}
__device__ __forceinline__ void ada_item(const GAS float* W, int ldw, int n0, const GAS float* bias, const GAS float* c_s, const GAS float* c_p, GAS float* outp, int ldo, LAS unsigned char* lds, int tid, int wave, int lane) {
    LAS bf16* Wt = (LAS bf16*)lds;
    const int kk = tid >> 4, n4 = tid & 15, r = lane & 15, g = lane >> 4;
    f32x4 acc[4], acc9[4];
#pragma unroll
    for (int q = 0; q < 4; ++q) { acc[q] = (f32x4){0.f, 0.f, 0.f, 0.f}; acc9[q] = (f32x4){0.f, 0.f, 0.f, 0.f}; }
    f32x4 wreg = *(const GAS f32x4*)(W + (size_t)kk * ldw + n0 + 4 * n4);
    for (int ks = 0; ks < 32; ++ks) {
        const int buf = ks & 1;
#pragma unroll
        for (int j = 0; j < 4; ++j) Wt[(buf * 64 + 4 * n4 + j) * 40 + kk] = (bf16)f2bf(wreg[j]);
        __syncthreads();
        if (ks + 1 < 32) wreg = *(const GAS f32x4*)(W + (size_t)((ks + 1) * 32 + kk) * ldw + n0 + 4 * n4);
        const bf16x8 af = silu8_bf16(c_s + (size_t)(16 * wave + r) * D + 32 * ks + 8 * g);
        bf16x8 bfr[4];
#pragma unroll
        for (int q = 0; q < 4; ++q) bfr[q] = *(const LAS bf16x8*)(Wt + (buf * 64 + 16 * q + r) * 40 + 8 * g);
#pragma unroll
        for (int q = 0; q < 4; ++q) acc[q] = __builtin_amdgcn_mfma_f32_16x16x32_bf16(af, bfr[q], acc[q], 0, 0, 0);
        if (wave == 0) {
            bf16x8 a9 = (bf16x8){0, 0, 0, 0, 0, 0, 0, 0};
            if (r < 2) a9 = silu8_bf16(c_p + (size_t)r * D + 32 * ks + 8 * g);
#pragma unroll
            for (int q = 0; q < 4; ++q) acc9[q] = __builtin_amdgcn_mfma_f32_16x16x32_bf16(a9, bfr[q], acc9[q], 0, 0, 0);
        }
    }
#pragma unroll
    for (int q = 0; q < 4; ++q) { const int n = n0 + 16 * q + r; const float bv = bias[n];
#pragma unroll
        for (int rg = 0; rg < 4; ++rg) { outp[(size_t)(16 * wave + 4 * g + rg) * ldo + n] = acc[q][rg] + bv;
            if (wave == 0 && g == 0 && rg < 2) outp[(size_t)(128 + rg) * ldo + n] = acc9[q][rg] + bv; } }
    __syncthreads();
}
__device__ __forceinline__ void p0_ada(volatile LAS unsigned long long* PT, LAS unsigned char* lds, int vcu, int G, int tid, int wave, int lane) {
    GAS unsigned char* ws = (GAS unsigned char*)ldptr(PT, 26);
    constexpr int PER_L = ADAW / 64, NIT = 4 * PER_L + 2048 / 64;
    for (int it = vcu; it < NIT; it += G) {
        if (it < 4 * PER_L) { const int l = it / PER_L, nb = it % PER_L;
            ada_item(PTF(I_WADA) + (size_t)l * D * ADAW, ADAW, 64 * nb, PTF(I_BADA) + (size_t)l * ADAW, PTF(I_CS), PTF(I_CP), (GAS float*)(ws + WS_ADA) + (size_t)l * NCOND * ADAW, ADAW, lds, tid, wave, lane); }
        else { const int nb = it - 4 * PER_L;
            ada_item(PTF(I_WADAKV), 2048, 64 * nb, PTF(I_BADAKV), PTF(I_CS), PTF(I_CP), (GAS float*)(ws + WS_ADAKV), 2048, lds, tid, wave, lane); }
    }
}
template <int MODE>
__device__ __forceinline__ void norm_pass(int gw, int NGW, int lane, const GAS float* H, const GAS float* xp, const GAS float* xs, GAS float* Hc,
                                          const GAS float* nw, const GAS float* sh, const GAS float* sc, int ldc, GAS bf16* XN,
                                          const GAS float* nw2, const GAS float* sh2, const GAS float* sc2, int ldc2, GAS bf16* XN2, GAS float* out) {
    for (int row = gw; row < MT; row += NGW) {
        const GAS float* src = MODE == 1 ? (row < MP ? xp + (size_t)row * D : xs + (size_t)(row - MP) * D) : H + (size_t)row * D;
        f32x4 v[4]; float ss = 0.f;
#pragma unroll
        for (int j = 0; j < 4; ++j) { v[j] = *(const GAS f32x4*)(src + 4 * lane + 256 * j); ss += (v[j][0] * v[j][0] + v[j][1] * v[j][1]) + (v[j][2] * v[j][2] + v[j][3] * v[j][3]); }
        const float rstd = 1.0f / sqrtf(wave_sum(ss) * (1.0f / D) + EPSF);
        const int ci = cond_of(row);
#pragma unroll
        for (int j = 0; j < 4; ++j) {
            const int c = 4 * lane + 256 * j;
            if (MODE == 1) *(GAS f32x4*)(Hc + (size_t)row * D + c) = v[j];
            if (MODE == 3) {
                const f32x4 w = *(const GAS f32x4*)(nw + c);
                GAS float* o = row < MP ? out + OY_P + (size_t)row * D + c : out + OY_S + (size_t)(row - MP) * D + c;
                *(GAS f32x4*)o = v[j] * rstd * w;
            } else {
                const f32x4 w = *(const GAS f32x4*)(nw + c), s1 = *(const GAS f32x4*)(sc + (size_t)ci * ldc + c), b1 = *(const GAS f32x4*)(sh + (size_t)ci * ldc + c);
                const f32x4 y = (v[j] * rstd * w) * (1.0f + s1) + b1;
                u32x2 p; p.x = cvt_pk(y[0], y[1]); p.y = cvt_pk(y[2], y[3]);
                *(GAS u32x2*)(XN + (size_t)row * D + c) = p;
                if (MODE == 2) {
                    const f32x4 w2 = *(const GAS f32x4*)(nw2 + c), s2 = *(const GAS f32x4*)(sc2 + (size_t)ci * ldc2 + c), b2 = *(const GAS f32x4*)(sh2 + (size_t)ci * ldc2 + c);
                    const f32x4 y2 = (v[j] * rstd * w2) * (1.0f + s2) + b2;
                    u32x2 p2; p2.x = cvt_pk(y2[0], y2[1]); p2.y = cvt_pk(y2[2], y2[3]);
                    *(GAS u32x2*)(XN2 + (size_t)row * D + c) = p2;
                }
            }
        }
    }
}
constexpr int SCT = 512, NSC = SEQ / SCT, TT = 32, NUNIT = 2 * 8 * NSC;
template <bool PASS_C>
__device__ __forceinline__ void scan_unit(int unit, const GAS bf16* QH, const GAS float* LF, const GAS bf16* VH, const GAS bf16* GH, GAS float* U, GAS float* DLOG, GAS bf16* OG, const GAS float* gnorm,
                                          LAS unsigned char* lds, int tid, int wave, int lane) {
    LAS float* Ft = (LAS float*)lds; LAS float* Qt = Ft + TT * 128; LAS float* Vt = Qt + TT * 128; LAS float* Ot = Vt + TT * 128;
    const int b = unit >> 7, h = (unit >> 4) & 7, sc = unit & 15, row0 = b * SEQ + sc * SCT, col0 = h * 128;
    const int vloc = lane & 15, kp = lane >> 4, v = 16 * wave + vloc;
    float s[32];
#pragma unroll
    for (int i = 0; i < 32; ++i) s[i] = PASS_C ? U[(size_t)unit * 16384 + (32 * kp + i) * 128 + v] : 0.f;
    const int sk = tid & 127, sq = tid >> 7;
    float slf = 0.f;
    for (int tile = 0; tile < SCT / TT; ++tile) {
        const int rowt = row0 + tile * TT;
#pragma unroll
        for (int j = 0; j < TT / 4; ++j) { const int t = sq + 4 * j; const size_t go = (size_t)(rowt + t) * D + col0 + sk;
            const float lf = LF[go]; Ft[t * 128 + sk] = __expf(lf); slf += lf;
            Vt[t * 128 + sk] = bf2f(VH[go]); if (PASS_C) Qt[t * 128 + sk] = bf2f(QH[go]); }
        __syncthreads();
        for (int t = 0; t < TT; ++t) {
            const float vv = Vt[t * 128 + v]; float acc = 0.f;
#pragma unroll
            for (int i4 = 0; i4 < 8; ++i4) {
                const f32x4 f = *(const LAS f32x4*)(Ft + t * 128 + 32 * kp + 4 * i4);
                f32x4 q = (f32x4){0.f, 0.f, 0.f, 0.f}; if (PASS_C) q = *(const LAS f32x4*)(Qt + t * 128 + 32 * kp + 4 * i4);
#pragma unroll
                for (int e = 0; e < 4; ++e) { const float sn = f[e] * (s[4 * i4 + e] - vv) + vv; s[4 * i4 + e] = sn; if (PASS_C) acc += q[e] * sn; }
            }
            if (PASS_C) { acc += __shfl_xor(acc, 16); acc += __shfl_xor(acc, 32); if (kp == 0) Ot[t * 128 + v] = acc; }
        }
        if (PASS_C) {
            __syncthreads();
#pragma unroll
            for (int r = 0; r < 4; ++r) { const int t = 4 * wave + r; const float x0 = Ot[t * 128 + lane], x1 = Ot[t * 128 + 64 + lane];
                const float rs = 1.0f / sqrtf(wave_sum(x0 * x0 + x1 * x1) * (1.0f / 128.0f) + EPSF);
                const size_t go = (size_t)(rowt + t) * D + col0 + lane;
                OG[go] = (bf16)f2bf(x0 * rs * gnorm[lane] * bf2f(GH[go])); OG[go + 64] = (bf16)f2bf(x1 * rs * gnorm[64 + lane] * bf2f(GH[go + 64])); }
        }
        __syncthreads();
    }
    if (!PASS_C) {
#pragma unroll
        for (int i = 0; i < 32; ++i) U[(size_t)unit * 16384 + (32 * kp + i) * 128 + v] = s[i];
        Ft[sq * 128 + sk] = slf; __syncthreads();
        if (tid < 128) DLOG[unit * 128 + tid] = (Ft[tid] + Ft[128 + tid]) + (Ft[256 + tid] + Ft[384 + tid]);
        __syncthreads();
    }
}
__device__ __forceinline__ void scan_combine(int layer, GAS float* U, const GAS float* DLOG, GAS float* out, int gt, int NGT) {
    for (int e = gt; e < 16 * 16384; e += NGT) {
        const int bh = e >> 14, idx = e & 16383, k = idx >> 7;
        float uv[NSC], dv[NSC];
#pragma unroll
        for (int sc = 0; sc < NSC; ++sc) { uv[sc] = U[(size_t)(bh * NSC + sc) * 16384 + idx]; dv[sc] = DLOG[(bh * NSC + sc) * 128 + k]; }
        float S = 0.f;
#pragma unroll
        for (int sc = 0; sc < NSC; ++sc) { U[(size_t)(bh * NSC + sc) * 16384 + idx] = S; S = __expf(dv[sc]) * S + uv[sc]; }
        const int b = bh >> 3, h = bh & 7;
        out[OST_P + (size_t)((b * 2 + layer) * 8 + h) * 16384 + idx] = S;
    }
}
__device__ __forceinline__ void scan_sample_unit(int su, int layer, const GAS bf16* QH, const GAS float* LF, const GAS bf16* VH, const GAS bf16* GH, const GAS float* S0g, GAS float* out, GAS bf16* OG, const GAS float* gnorm,
                                                 LAS unsigned char* lds, int tid, int wave, int lane) {
    LAS float* red = (LAS float*)lds; LAS float* Ot = red + 512;
    const int b = su >> 3, h = su & 7, row = MP + b, col0 = h * 128, v = tid & 127, kq = tid >> 7;
    const size_t so = (size_t)((b * 2 + layer) * 8 + h) * 16384;
    const GAS float* S0 = S0g + so; GAS float* S1 = out + OST_S + so;
    const float vv = bf2f(VH[(size_t)row * D + col0 + v]); float acc = 0.f;
#pragma unroll 8
    for (int i = 0; i < 32; ++i) { const int k = 32 * kq + i; const size_t go = (size_t)row * D + col0 + k;
        const float f = __expf(LF[go]), q = bf2f(QH[go]);
        const float sn = f * (S0[k * 128 + v] - vv) + vv; S1[k * 128 + v] = sn; acc += q * sn; }
    red[kq * 128 + v] = acc; __syncthreads();
    if (tid < 128) Ot[tid] = (red[tid] + red[128 + tid]) + (red[256 + tid] + red[384 + tid]);
    __syncthreads();
    if (wave == 0) { const float x0 = Ot[lane], x1 = Ot[64 + lane]; const float rs = 1.0f / sqrtf(wave_sum(x0 * x0 + x1 * x1) * (1.0f / 128.0f) + EPSF);
        const size_t go = (size_t)row * D + col0 + lane;
        OG[go] = (bf16)f2bf(x0 * rs * gnorm[lane] * bf2f(GH[go])); OG[go + 64] = (bf16)f2bf(x1 * rs * gnorm[64 + lane] * bf2f(GH[go + 64])); }
    __syncthreads();
}
__device__ __forceinline__ int t5_bucket(int d) {
    if (d < 16) return d;
    int lg = 16 + (int)(logf((float)d * (1.0f / 16.0f)) / 2.0794415416798357f * 16.0f);
    return lg > 31 ? 31 : lg;
}
__device__ __forceinline__ void attn_unit(int unit, int jl, const GAS bf16* Q, const GAS bf16* KSH, const GAS bf16* VSH, GAS bf16* ATT, const GAS float* sinks, const GAS float* relb, LAS unsigned char* ldsh, int ht) {
    LAS bf16* Kt = (LAS bf16*)ldsh; LAS bf16* Vt = Kt + 192 * 64; LAS float* bT = (LAS float*)(Vt + 192 * 64);
    const int b = unit >> 9, kv = (unit >> 7) & 3, qb = unit & 127, t0 = qb * 64, rowbase = b * SEQ;
    for (int idx = ht; idx < 192 * 8; idx += 256) { const int s = idx >> 3, ch = idx & 7, sabs = t0 - 128 + s;
        u32x4 kx = (u32x4){0u, 0u, 0u, 0u}, vx = (u32x4){0u, 0u, 0u, 0u};
        if (sabs >= 0) { kx = *(const GAS u32x4*)(KSH + (size_t)(rowbase + sabs) * 256 + kv * 64 + ch * 8); vx = *(const GAS u32x4*)(VSH + (size_t)(rowbase + sabs) * 256 + kv * 64 + ch * 8); }
        *(LAS u32x4*)(Kt + s * 64 + ch * 8) = kx; *(LAS u32x4*)(Vt + s * 64 + ch * 8) = vx; }
    for (int idx = ht; idx < 512; idx += 256) { const int g = idx >> 7, d = idx & 127; bT[idx] = relb[t5_bucket(d) * 16 + kv * 4 + g]; }
    __syncthreads();
    const int qi = ht & 63, g = ht >> 6, t = t0 + qi, head = kv * 4 + g;
    float q[64], o[64];
    { const GAS bf16* qp = Q + (size_t)(rowbase + t) * D + head * 64;
#pragma unroll
      for (int c8 = 0; c8 < 8; ++c8) { const u32x4 w = *(const GAS u32x4*)(qp + c8 * 8);
#pragma unroll
        for (int e = 0; e < 4; ++e) { q[c8 * 8 + 2 * e] = __uint_as_float(w[e] << 16); q[c8 * 8 + 2 * e + 1] = __uint_as_float(w[e] & 0xffff0000u); } } }
#pragma unroll
    for (int d = 0; d < 64; ++d) o[d] = 0.f;
    float m = sinks[jl * 16 + head], lsum = 1.0f;
    for (int s = 0; s < 192; ++s) {
        const int dist = qi + 128 - s, sabs = t0 - 128 + s;
        const bool valid = (dist >= 0) && (dist < 128) && (sabs >= 0);
        if (!__any(valid)) continue;
        float dot = 0.f;
#pragma unroll
        for (int c8 = 0; c8 < 8; ++c8) { const u32x4 w = *(const LAS u32x4*)(Kt + s * 64 + c8 * 8);
#pragma unroll
            for (int e = 0; e < 4; ++e) { dot += q[c8 * 8 + 2 * e] * __uint_as_float(w[e] << 16); dot += q[c8 * 8 + 2 * e + 1] * __uint_as_float(w[e] & 0xffff0000u); } }
        const float scv = dot + bT[g * 128 + (dist & 127)];
        const float mn = valid ? fmaxf(m, scv) : m;
        const float alpha = __expf(m - mn), p = valid ? __expf(scv - mn) : 0.f;
        lsum = lsum * alpha + p; m = mn;
#pragma unroll
        for (int c8 = 0; c8 < 8; ++c8) { const u32x4 w = *(const LAS u32x4*)(Vt + s * 64 + c8 * 8);
#pragma unroll
            for (int e = 0; e < 4; ++e) { o[c8 * 8 + 2 * e] = o[c8 * 8 + 2 * e] * alpha + p * __uint_as_float(w[e] << 16); o[c8 * 8 + 2 * e + 1] = o[c8 * 8 + 2 * e + 1] * alpha + p * __uint_as_float(w[e] & 0xffff0000u); } }
    }
    { const float inv = 1.0f / lsum; GAS bf16* op = ATT + (size_t)(rowbase + t) * D + head * 64;
#pragma unroll
      for (int c8 = 0; c8 < 8; ++c8) { u32x4 w;
#pragma unroll
        for (int e = 0; e < 4; ++e) w[e] = cvt_pk(o[c8 * 8 + 2 * e] * inv, o[c8 * 8 + 2 * e + 1] * inv);
        *(GAS u32x4*)(op + c8 * 8) = w; } }
    __syncthreads();
}
__device__ __forceinline__ void attn_sample_item(int wi, int jl, const GAS bf16* Q, const GAS bf16* KSH, const GAS bf16* VSH, const GAS float* ck, const GAS float* cv, GAS bf16* ATT, const GAS float* sinks, const GAS float* relb,
                                                 LAS float* pbuf, int lane) {
    const int b = wi >> 4, head = wi & 15, kv = head >> 2, row = MP + b;
    float q[64];
    { const GAS bf16* qp = Q + (size_t)row * D + head * 64;
#pragma unroll
      for (int c8 = 0; c8 < 8; ++c8) { const u32x4 w = *(const GAS u32x4*)(qp + c8 * 8);
#pragma unroll
        for (int e = 0; e < 4; ++e) { q[c8 * 8 + 2 * e] = __uint_as_float(w[e] << 16); q[c8 * 8 + 2 * e + 1] = __uint_as_float(w[e] & 0xffff0000u); } } }
    float scv[2];
#pragma unroll
    for (int hh = 0; hh < 2; ++hh) { const int jj = lane + 64 * hh; const GAS float* kp = ck + (size_t)((b * 128 + jj) * 4 + kv) * 64; float dot = 0.f;
#pragma unroll
        for (int c4 = 0; c4 < 16; ++c4) { const f32x4 kx = *(const GAS f32x4*)(kp + 4 * c4); dot += q[4 * c4] * kx[0] + q[4 * c4 + 1] * kx[1] + q[4 * c4 + 2] * kx[2] + q[4 * c4 + 3] * kx[3]; }
        scv[hh] = jj >= 1 ? dot + relb[t5_bucket(128 - jj) * 16 + head] : -1e30f; }
    float scn;
    { const GAS bf16* kp = KSH + (size_t)row * 256 + kv * 64; float dot = 0.f;
#pragma unroll
      for (int c8 = 0; c8 < 8; ++c8) { const u32x4 w = *(const GAS u32x4*)(kp + c8 * 8);
#pragma unroll
        for (int e = 0; e < 4; ++e) { dot += q[c8 * 8 + 2 * e] * __uint_as_float(w[e] << 16); dot += q[c8 * 8 + 2 * e + 1] * __uint_as_float(w[e] & 0xffff0000u); } }
      scn = dot + relb[head]; }
    const float sink = sinks[jl * 16 + head];
    const float m = fmaxf(fmaxf(sink, scn), wave_max(fmaxf(scv[0], scv[1])));
    const float p0 = __expf(scv[0] - m), p1 = __expf(scv[1] - m), pn = __expf(scn - m);
    const float lsum = wave_sum(p0 + p1) + pn + __expf(sink - m);
    pbuf[lane] = p0; pbuf[64 + lane] = p1;
    LDS_WAIT(); asm volatile("" ::: "memory");
    float o = pn * bf2f(VSH[(size_t)row * 256 + kv * 64 + lane]);
#pragma unroll 8
    for (int jj = 1; jj < 128; ++jj) o += pbuf[jj] * cv[(size_t)((b * 128 + jj) * 4 + kv) * 64 + lane];
    ATT[(size_t)row * D + head * 64 + lane] = (bf16)f2bf(o / lsum);
    LDS_WAIT(); asm volatile("" ::: "memory");
}
__global__ void __launch_bounds__(NWAVES * 64, 2) yoco_fwd(Args args) {
    extern __shared__ __attribute__((aligned(16))) unsigned char lds_raw[];
    LAS unsigned char* lds = (LAS unsigned char*)lds_raw;
    volatile LAS unsigned* MISC = (volatile LAS unsigned*)(lds + MISC_OFF);
    const int tid0 = threadIdx.x, G0 = gridDim.x, bx0 = blockIdx.x;
    const int tid = tid0;
    gu32* ctl = (gu32*)(args.ws + WS_CTL);
    for (int u = tid; u < (LDS_BYTES - LDSCTL_OFF) / 4; u += NWAVES * 64) ((LAS unsigned*)(lds + LDSCTL_OFF))[u] = 0u;
    __syncthreads();
    XcdBarrier bar = xcd_barrier_post((unsigned*)(ctl + CW_BAR), MISC + 8);
#define GRID_BAR() xcd_barrier(bar)

    volatile LAS unsigned long long* PT = (volatile LAS unsigned long long*)(lds + PTAB_OFF);
    if (tid < 25) PT[tid] = (unsigned long long)args.in[tid];
    if (tid == 25) PT[25] = (unsigned long long)args.out;
    if (tid == 26) PT[26] = (unsigned long long)args.ws;
    __syncthreads();
#define PF(i) ((const GAS float*)ldptr(PT, (i)))
#define POUT ((GAS float*)ldptr(PT, 25))
#define PWS ((GAS unsigned char*)ldptr(PT, 26))

    enum { T_P0, T_NORMX, T_INPROJ, T_SCANA, T_SCANB, T_SCANC, T_QPROJ, T_ATTN, T_RES, T_NORM, T_FFN1, T_KV };
    constexpr int NPH = 2 + 2 * 9 + 1 + 2 * 7;
#pragma unroll 1
    for (int ph = 0; ph < NPH; ++ph) {
        int tid = tid0, G = G0, bx = bx0; asm volatile("" : "+v"(tid)); asm volatile("" : "+s"(G), "+s"(bx));
        const int lane = tid & 63, wave = __builtin_amdgcn_readfirstlane(tid >> 6);
        const int vcu = (G % 8 == 0) ? (bx % 8) * (G / 8) + bx / 8 : bx, gw = vcu * NWAVES + wave, NGW = G * NWAVES;
        int type, l = 0, half = 0;
        if (ph == 0) type = T_P0;
        else if (ph == 1) type = T_NORMX;
        else { const int p = ph - 2;
            if (p < 18) { l = p >= 9 ? 1 : 0; const int st = p - 9 * l;
                type = st == 0 ? T_INPROJ : st == 1 ? T_SCANA : st == 2 ? T_SCANB : st == 3 ? T_SCANC : st == 4 ? T_RES : st == 5 ? T_NORM : st == 6 ? T_FFN1 : st == 7 ? T_RES : T_NORM; half = st >= 6 ? 1 : 0; }
            else if (p == 18) { type = T_KV; l = 1; }
            else { const int p2 = p - 19; l = 2 + (p2 >= 7 ? 1 : 0); const int st = p2 - 7 * (l - 2);
                type = st == 0 ? T_QPROJ : st == 1 ? T_ATTN : st == 2 ? T_RES : st == 3 ? T_NORM : st == 4 ? T_FFN1 : st == 5 ? T_RES : T_NORM; half = st >= 4 ? 1 : 0; } }
        if (type == T_P0) {
            p0_ada(PT, lds, vcu, G, tid, wave, lane);
            p0_transposes(PT, lds, gw, NGW, wave, lane);
        } else if (type == T_NORMX) {
            GAS unsigned char* ws = PWS; const GAS float* ADA = (const GAS float*)(ws + WS_ADA);
            norm_pass<1>(gw, NGW, lane, nullptr, PF(I_XP), PF(I_XS), (GAS float*)(ws + WS_H), PF(I_NORMW), ADA + 0 * D, ADA + 1 * D, ADAW, (GAS bf16*)(ws + WS_XN), nullptr, nullptr, nullptr, 0, nullptr, nullptr);
        } else if (type == T_INPROJ) {
            GAS unsigned char* ws = PWS; const GAS float* lb = PF(I_LB);
            pg8::Gemm g{(const GAS bf16*)(ws + WS_XN), (const GAS bf16*)(ws + WS_WIN) + (size_t)l * WIN_SZ, MPAD, 4096, D}; pg8::StaticOrder S; S.init(MPAD, 4096, G, bx);
            EpiInProj E{ws, lb, lb + D, l};
            pg8::gemm_phase<EpiInProj, pg8::StaticOrder, true, true>(lds + RING_OFF, g, S, E, tid);
        } else if (type == T_SCANA) {
            GAS unsigned char* ws = PWS; const GAS float* gn = PF(I_GNORM) + l * 128;
            for (int u = vcu; u < NUNIT; u += G) scan_unit<false>(u, (const GAS bf16*)(ws + WS_QH), (const GAS float*)(ws + WS_LF), (const GAS bf16*)(ws + WS_VH), (const GAS bf16*)(ws + WS_GH), (GAS float*)(ws + WS_SCAN), (GAS float*)(ws + WS_DLOG), (GAS bf16*)(ws + WS_OG), gn, lds, tid, wave, lane);
            const GAS float* st0 = PF(I_STATE); GAS float* out = POUT;
            for (int su = vcu; su < MS * 8; su += G) scan_sample_unit(su, l, (const GAS bf16*)(ws + WS_QH), (const GAS float*)(ws + WS_LF), (const GAS bf16*)(ws + WS_VH), (const GAS bf16*)(ws + WS_GH), st0, out, (GAS bf16*)(ws + WS_OG), gn, lds, tid, wave, lane);
        } else if (type == T_SCANB) {
            GAS unsigned char* ws = PWS; scan_combine(l, (GAS float*)(ws + WS_SCAN), (const GAS float*)(ws + WS_DLOG), POUT, vcu * NWAVES * 64 + tid, G * NWAVES * 64);
        } else if (type == T_SCANC) {
            GAS unsigned char* ws = PWS; const GAS float* gn = PF(I_GNORM) + l * 128;
            for (int u = vcu; u < NUNIT; u += G) scan_unit<true>(u, (const GAS bf16*)(ws + WS_QH), (const GAS float*)(ws + WS_LF), (const GAS bf16*)(ws + WS_VH), (const GAS bf16*)(ws + WS_GH), (GAS float*)(ws + WS_SCAN), (GAS float*)(ws + WS_DLOG), (GAS bf16*)(ws + WS_OG), gn, lds, tid, wave, lane);
        } else if (type == T_QPROJ) {
            GAS unsigned char* ws = PWS;
            pg8::Gemm g{(const GAS bf16*)(ws + WS_XN), (const GAS bf16*)(ws + WS_WQ) + (size_t)(l - 2) * WOA_SZ, MPAD, D, D}; pg8::StaticOrder S; S.init(MPAD, D, G, bx);
            EpiQ E{(GAS bf16*)(ws + WS_QH)};
            pg8::gemm_phase<EpiQ, pg8::StaticOrder, true, true>(lds + RING_OFF, g, S, E, tid);
        } else if (type == T_ATTN) {
            GAS unsigned char* ws = PWS; const GAS float* sinks = PF(I_SINKS); const GAS float* relb = PF(I_RELB); const int jl = l - 2;
            const int hf = wave >> 2, ht = tid & 255;
            for (int it = vcu; it < 512; it += G) attn_unit(2 * it + hf, jl, (const GAS bf16*)(ws + WS_QH), (const GAS bf16*)(ws + WS_KSH), (const GAS bf16*)(ws + WS_VSH), (GAS bf16*)(ws + WS_OG), sinks, relb, lds + hf * 53248, ht);
            LAS float* pbuf = (LAS float*)(lds + 106496 + wave * 512);
            const GAS float* ck = PF(I_CK); const GAS float* cv = PF(I_CV);
            for (int wi = gw; wi < MS * 16; wi += NGW) attn_sample_item(wi, jl, (const GAS bf16*)(ws + WS_QH), (const GAS bf16*)(ws + WS_KSH), (const GAS bf16*)(ws + WS_VSH), ck, cv, (GAS bf16*)(ws + WS_OG), sinks, relb, pbuf, lane);
        } else if (type == T_FFN1) {
            GAS unsigned char* ws = PWS;
            pg8::Gemm g{(const GAS bf16*)(ws + WS_XN), (const GAS bf16*)(ws + WS_WF1) + (size_t)l * WF1_SZ, MPAD, NFF2, D}; pg8::StaticOrder S; S.init(MPAD, NFF2, G, bx);
            EpiSwiGLU E{(GAS bf16*)(ws + WS_ACT)};
            pg8::gemm_phase<EpiSwiGLU, pg8::StaticOrder, true, true>(lds + RING_OFF, g, S, E, tid);
        } else if (type == T_RES) {
            GAS unsigned char* ws = PWS;
            const GAS bf16* Ap = half == 0 ? (const GAS bf16*)(ws + WS_OG) : (const GAS bf16*)(ws + WS_ACT);
            const GAS bf16* Bp = half == 0 ? (l < 2 ? (const GAS bf16*)(ws + WS_WOA) + (size_t)l * WOA_SZ : (const GAS bf16*)(ws + WS_WOB) + (size_t)(l - 2) * WOA_SZ) : (const GAS bf16*)(ws + WS_WF2) + (size_t)l * WF2_SZ;
            pg8::Gemm g{Ap, Bp, MPAD, D, half == 0 ? D : DFF}; pg8::StaticOrder S; S.init(MPAD, D, G, bx);
            EpiRes E{(GAS float*)(ws + WS_H), (const GAS float*)(ws + WS_ADA) + (size_t)l * NCOND * ADAW + (half == 0 ? 2 : 5) * D};
            pg8::gemm_phase<EpiRes, pg8::StaticOrder, true, true>(lds + RING_OFF, g, S, E, tid);
        } else if (type == T_NORM) {
            GAS unsigned char* ws = PWS; const GAS float* NW = PF(I_NORMW); const GAS float* ADAl = (const GAS float*)(ws + WS_ADA) + (size_t)l * NCOND * ADAW; const GAS float* ADAn = ADAl + NCOND * ADAW;
            const GAS float* Hc = (const GAS float*)(ws + WS_H); GAS bf16* XN = (GAS bf16*)(ws + WS_XN);
            if (half == 0) norm_pass<0>(gw, NGW, lane, Hc, nullptr, nullptr, nullptr, NW + (l * 2 + 1) * D, ADAl + 3 * D, ADAl + 4 * D, ADAW, XN, nullptr, nullptr, nullptr, 0, nullptr, nullptr);
            else if (l == 3) norm_pass<3>(gw, NGW, lane, Hc, nullptr, nullptr, nullptr, PF(I_FNORM), nullptr, nullptr, 0, nullptr, nullptr, nullptr, nullptr, 0, nullptr, POUT);
            else if (l == 1) norm_pass<2>(gw, NGW, lane, Hc, nullptr, nullptr, nullptr, NW + ((l + 1) * 2) * D, ADAn + 0 * D, ADAn + 1 * D, ADAW, XN,
                                          PF(I_KVNORM), (const GAS float*)(ws + WS_ADAKV), (const GAS float*)(ws + WS_ADAKV) + D, 2048, (GAS bf16*)(ws + WS_XNKV), nullptr);
            else norm_pass<0>(gw, NGW, lane, Hc, nullptr, nullptr, nullptr, NW + ((l + 1) * 2) * D, ADAn + 0 * D, ADAn + 1 * D, ADAW, XN, nullptr, nullptr, nullptr, 0, nullptr, nullptr);
        } else {
            { GAS unsigned char* ws = PWS; GAS float* out = POUT;
              pg8::Gemm g{(const GAS bf16*)(ws + WS_XNKV), (const GAS bf16*)(ws + WS_WKV), MPAD, 512, D}; pg8::StaticOrder S; S.init(MPAD, 512, G, bx);
              EpiKV E{(GAS bf16*)(ws + WS_KSH), (GAS bf16*)(ws + WS_VSH), out};
              pg8::gemm_phase<EpiKV, pg8::StaticOrder, true, true>(lds + RING_OFF, g, S, E, tid); }
            { GAS float* out = POUT; const GAS float* ck = PF(I_CK); const GAS float* cv = PF(I_CV);
              const int gt = vcu * NWAVES * 64 + tid, NGT = G * NWAVES * 64;
              for (int e = gt; e < MS * 127 * 64; e += NGT) { const int b = e / (127 * 64), r = e % (127 * 64);
                  *(GAS f32x4*)(out + OCK_S + (size_t)b * 32768 + 4 * r) = *(const GAS f32x4*)(ck + (size_t)b * 32768 + 256 + 4 * r);
                  *(GAS f32x4*)(out + OCV_S + (size_t)b * 32768 + 4 * r) = *(const GAS f32x4*)(cv + (size_t)b * 32768 + 256 + 4 * r); } }
        }
        GRID_BAR();
    }
}

extern "C" void kernel_launch(void* const* d_in, const int* in_sizes, int n_in, void* d_out, int out_size, void* d_ws, size_t ws_size, hipStream_t stream) {
    static int grid = 0;
    if (grid == 0) {
        if (n_in != 25 || (size_t)out_size != OUT_TOTAL || ws_size < WS_END) { fprintf(stderr, "kernel_launch: unexpected problem: n_in %d out %d ws %zu (need >= %zu)\n", n_in, out_size, ws_size, (size_t)WS_END); grid = -1; return; }
        int dev = 0, cus = 0, per_cu = 0;
        if (hipGetDevice(&dev) != hipSuccess || hipDeviceGetAttribute(&cus, hipDeviceAttributeMultiprocessorCount, dev) != hipSuccess) { fprintf(stderr, "kernel_launch: device query failed\n"); grid = -1; return; }
        if (hipFuncSetAttribute((const void*)yoco_fwd, hipFuncAttributeMaxDynamicSharedMemorySize, LDS_BYTES) != hipSuccess) { fprintf(stderr, "kernel_launch: hipFuncSetAttribute failed\n"); grid = -1; return; }
        if (hipOccupancyMaxActiveBlocksPerMultiprocessor(&per_cu, (const void*)yoco_fwd, NWAVES * 64, LDS_BYTES) != hipSuccess || per_cu < 1)
            fprintf(stderr, "kernel_launch: note: occupancy query reports %d workgroups per CU\n", per_cu);
        (void)hipGetLastError();
        grid = cus;
    }
    if (grid < 0) return;
    if (hipMemsetAsync((char*)d_ws + WS_CTL, 0, CTL_ZERO_BYTES, stream) != hipSuccess) { fprintf(stderr, "kernel_launch: hipMemsetAsync failed\n"); return; }
    Args a{};
    for (int i = 0; i < 25; ++i) a.in[i] = (const GAS float*)d_in[i];
    a.out = (GAS float*)d_out; a.ws = (GAS unsigned char*)d_ws;
    hipLaunchKernelGGL(yoco_fwd, dim3(grid), dim3(NWAVES * 64), LDS_BYTES, stream, a);
    const hipError_t le = hipPeekAtLastError();
    if (le != hipSuccess) fprintf(stderr, "kernel_launch: launch failed: %s\n", hipGetErrorName(le));
}
```

```cpp
#include <hip/hip_runtime.h>
#include <cstdio>
#include <cstdint>
#define GAS __attribute__((address_space(1)))
#define LAS __attribute__((address_space(3)))
namespace pg8 {
#define PG8_LAS __attribute__((address_space(3)))
typedef unsigned short bf16_t;
typedef short bf16x8 __attribute__((ext_vector_type(8)));
typedef float f32x4 __attribute__((ext_vector_type(4)));
typedef unsigned u32x4 __attribute__((ext_vector_type(4)));
constexpr int BM = 256, BK = 64, HALF = 128, HTB = HALF * BK * 2  , STAGE_BYTES = 8 * HTB, NXCD = 8, WGM = 8;

__host__ __device__ __forceinline__ int lds_byte(int r, int c) { const int st = (r >> 4) * 2 + (c >> 5), rr = r & 15, cc = c & 31, ob = rr * 64 + cc * 2; return st * 1024 + (ob ^ (((ob >> 9) & 1) << 5)); }
__host__ __device__ __forceinline__ void stage_rc(int b, int& R, int& C) { const int st = b / 1024, sb = b % 1024, swz = sb ^ (((sb >> 9) & 1) << 5); R = (st >> 1) * 16 + swz / 64; C = (st & 1) * 32 + (swz % 64) / 2; }
__host__ __device__ __forceinline__ int perm32(int rho) { const int n = rho >> 4, i = rho & 15; return 8 * (i >> 2) + 4 * n + (i & 3); }

struct Unit { int pm, pn; };
struct Gemm { const GAS bf16_t* A; const GAS bf16_t* Bt; int M, N, K; };

struct StaticOrder {
    int nM, nN, nwg, G, c;
    __host__ __device__ void init(int M, int N, int G_, int c_) { nM = M / BM; nN = N / BM; nwg = nM * nN; G = G_; c = c_; }
    __host__ __device__ bool next(int i, Unit& u) const {
        const long L = (long)i * G + c; if (L >= nwg) return false;
        int wgid = (int)L; { const int q = nwg / NXCD, r = nwg % NXCD, xcd = wgid % NXCD, off = wgid / NXCD; wgid = (xcd < r ? xcd * (q + 1) : r * (q + 1) + (xcd - r) * q) + off; }
        const int nig = WGM * nN, gid = wgid / nig, fm = gid * WGM, gsz = (nM - fm) < WGM ? (nM - fm) : WGM;
        u.pm = fm + ((wgid % nig) % gsz); u.pn = (wgid % nig) / gsz; return true;
    }
    __device__ __forceinline__ void a_ready(const Unit&) const {}
    __device__ __forceinline__ void done(const Unit&) const {}
};

template <class Epi, class Sched, bool ALIGN_EPI = false, bool SP2 = false>
__device__ __forceinline__ void gemm_phase(PG8_LAS unsigned char* lds, const Gemm g, const Sched& S, const Epi& E, const int tid_in) {
    const int tid = tid_in, wid = __builtin_amdgcn_readfirstlane(tid >> 6), lane = tid & 63, wr = wid >> 2, wc = wid & 3, fr = lane & 15, fq = lane >> 4;
    const int K = g.K, nt = K / BK;
    unsigned voffA[2], voffB[2];
#pragma unroll
    for (int i = 0; i < 2; ++i) { int R, C; stage_rc(tid * 16 + i * 8192, R, C); const int Rb = Epi::PERM ? ((R & ~31) + perm32(R & 31)) : R;
        voffA[i] = (unsigned)(R * K + C) * 2u; voffB[i] = (unsigned)(Rb * K + C) * 2u; }
    const size_t kstep = (size_t)(BK * 2);
    const size_t hstep = (size_t)HALF * K * 2;
    const size_t tstep = 2 * hstep;
    const unsigned ldsw = (unsigned)wid * 1024u;
    const int aoff = lds_byte(wr * 64 + fr, fq * 8), boff = lds_byte(wc * 32 + fr, fq * 8);
#define PG8_SA(b, h) (((b) * 2 + (h)) * HTB)
#define PG8_SB(b, h) ((4 + (b) * 2 + (h)) * HTB)
#define PG8_STAGE(bufoff, gbase, voff) do { _Pragma("unroll") for (int _i = 0; _i < 2; ++_i) \
        __builtin_amdgcn_global_load_lds((const GAS unsigned*)((const GAS char*)(gbase) + (voff)[_i]), (PG8_LAS unsigned*)(lds + (bufoff) + ldsw + _i * 8192), 16, 0, 0); } while (0)
#define PG8_LDA(dst, b, h) do { _Pragma("unroll") for (int m = 0; m < 4; ++m) _Pragma("unroll") for (int k = 0; k < 2; ++k) dst[m][k] = *(const PG8_LAS bf16x8*)(lds + PG8_SA(b, h) + aoff + m * 2048 + k * 1024); } while (0)
#define PG8_LDB(dst, b, h) do { _Pragma("unroll") for (int n = 0; n < 2; ++n) _Pragma("unroll") for (int k = 0; k < 2; ++k) dst[n][k] = *(const PG8_LAS bf16x8*)(lds + PG8_SB(b, h) + boff + n * 2048 + k * 1024); } while (0)
#define PG8_MMA(ai, bj, At, Bt) do { __builtin_amdgcn_s_setprio(1); _Pragma("unroll") for (int m = 0; m < 4; ++m) _Pragma("unroll") for (int n = 0; n < 2; ++n) _Pragma("unroll") for (int k = 0; k < 2; ++k) \
        acc[ai][bj][m][n] = __builtin_amdgcn_mfma_f32_16x16x32_bf16(Bt[n][k], At[m][k], acc[ai][bj][m][n], 0, 0, 0); __builtin_amdgcn_s_setprio(0); } while (0)
#define PG8_WAIT_V(n) asm volatile("s_waitcnt vmcnt(" #n ")" ::: "memory")
#define PG8_WAIT_L(n) asm volatile("s_waitcnt lgkmcnt(" #n ")" ::: "memory")
#define PG8_BAR __builtin_amdgcn_s_barrier()
#define PG8_SCHED __builtin_amdgcn_sched_barrier(0)
    Unit cur, nxt; int ui = 0;
    if (!S.next(0, cur)) return;
    f32x4 acc[2][2][4][2];
#pragma unroll
    for (int a = 0; a < 2; ++a)
#pragma unroll
        for (int b = 0; b < 2; ++b)
#pragma unroll
            for (int m = 0; m < 4; ++m)
#pragma unroll
                for (int n = 0; n < 2; ++n) acc[a][b][m][n] = (f32x4){0.f, 0.f, 0.f, 0.f};
    bf16x8 At[4][2], B0[2][2], B1[2][2];
    const GAS char* cA = (const GAS char*)g.A + (size_t)cur.pm * tstep; const GAS char* cB = (const GAS char*)g.Bt + (size_t)cur.pn * tstep;
    S.a_ready(cur);
    if constexpr (SP2) {
        PG8_STAGE(PG8_SB(0, 0), cB, voffB); PG8_STAGE(PG8_SB(0, 1), cB + hstep, voffB); PG8_STAGE(PG8_SA(0, 0), cA, voffA); PG8_STAGE(PG8_SA(0, 1), cA + hstep, voffA);
        if (wr == 1) PG8_BAR;
        PG8_WAIT_V(2); PG8_BAR;
        PG8_STAGE(PG8_SB(1, 0), cB + kstep, voffB); PG8_STAGE(PG8_SA(1, 0), cA + kstep, voffA); PG8_STAGE(PG8_SB(1, 1), cB + hstep + kstep, voffB);
        PG8_WAIT_V(6); PG8_BAR;
    } else {
        PG8_STAGE(PG8_SB(0, 0), cB, voffB); PG8_STAGE(PG8_SA(0, 0), cA, voffA); PG8_STAGE(PG8_SB(0, 1), cB + hstep, voffB); PG8_STAGE(PG8_SA(0, 1), cA + hstep, voffA);
        if (wr == 1) PG8_BAR;
        PG8_WAIT_V(4); PG8_BAR;
        PG8_STAGE(PG8_SB(1, 0), cB + kstep, voffB); PG8_STAGE(PG8_SA(1, 0), cA + kstep, voffA); PG8_STAGE(PG8_SB(1, 1), cB + hstep + kstep, voffB);
        PG8_WAIT_V(6); PG8_BAR;
    }
    for (;;) {
        const bool has_next = S.next(ui + 1, nxt);
        const GAS char* nA = has_next ? (const GAS char*)g.A + (size_t)nxt.pm * tstep : cA; const GAS char* nB = has_next ? (const GAS char*)g.Bt + (size_t)nxt.pn * tstep : cB;
        for (int t = 0; t < nt; t += 2) {
            const bool last = (t == nt - 2);
            const GAS char* a1 = cA + (size_t)(t + 1) * kstep;
            const GAS char* a2 = last ? nA : cA + (size_t)(t + 2) * kstep; const GAS char* b2 = last ? nB : cB + (size_t)(t + 2) * kstep;
            const GAS char* a3 = a2 + kstep; const GAS char* b3 = b2 + kstep;
            if (last && has_next) S.a_ready(nxt);
            if constexpr (SP2) {
            PG8_LDB(B0, 0, 0); PG8_LDB(B1, 0, 1); PG8_SCHED; PG8_LDA(At, 0, 0); PG8_STAGE(PG8_SA(1, 1), a1 + hstep, voffA);
            PG8_WAIT_V(8); PG8_WAIT_L(0); PG8_BAR; PG8_MMA(0, 0, At, B0); PG8_MMA(0, 1, At, B1); PG8_BAR; PG8_SCHED;
            PG8_LDA(At, 0, 1); PG8_STAGE(PG8_SB(0, 0), b2, voffB); PG8_STAGE(PG8_SB(0, 1), b2 + hstep, voffB); PG8_STAGE(PG8_SA(0, 0), a2, voffA);
            PG8_WAIT_V(8); PG8_WAIT_L(0); PG8_BAR; PG8_MMA(1, 0, At, B0); PG8_MMA(1, 1, At, B1); PG8_BAR; PG8_SCHED;
            PG8_LDB(B0, 1, 0); PG8_LDB(B1, 1, 1); PG8_SCHED; PG8_LDA(At, 1, 0); PG8_STAGE(PG8_SA(0, 1), a2 + hstep, voffA);
            PG8_WAIT_V(8); PG8_WAIT_L(0); PG8_BAR; PG8_MMA(0, 0, At, B0); PG8_MMA(0, 1, At, B1); PG8_BAR; PG8_SCHED;
            PG8_LDA(At, 1, 1); PG8_STAGE(PG8_SB(1, 0), b3, voffB); PG8_STAGE(PG8_SB(1, 1), b3 + hstep, voffB); PG8_STAGE(PG8_SA(1, 0), a3, voffA);
            PG8_WAIT_V(8); PG8_WAIT_L(0); PG8_BAR; PG8_MMA(1, 0, At, B0); PG8_MMA(1, 1, At, B1); PG8_BAR; PG8_SCHED;
            } else {
            PG8_LDB(B0, 0, 0); PG8_SCHED; PG8_LDA(At, 0, 0); PG8_STAGE(PG8_SA(1, 1), a1 + hstep, voffA);
            PG8_WAIT_L(8); PG8_BAR; PG8_WAIT_L(0); PG8_MMA(0, 0, At, B0); PG8_BAR; PG8_SCHED;
            PG8_LDB(B1, 0, 1); PG8_STAGE(PG8_SB(0, 0), b2, voffB);
            PG8_BAR; PG8_WAIT_L(0); PG8_MMA(0, 1, At, B1); PG8_BAR;
            PG8_LDA(At, 0, 1); PG8_STAGE(PG8_SA(0, 0), a2, voffA);
            PG8_BAR; PG8_WAIT_L(0); PG8_MMA(1, 0, At, B0); PG8_BAR; PG8_SCHED;
            PG8_STAGE(PG8_SB(0, 1), b2 + hstep, voffB);
            PG8_WAIT_V(6); PG8_BAR; PG8_MMA(1, 1, At, B1); PG8_BAR;
            PG8_LDB(B0, 1, 0); PG8_SCHED; PG8_LDA(At, 1, 0); PG8_STAGE(PG8_SA(0, 1), a2 + hstep, voffA);
            PG8_WAIT_L(8); PG8_BAR; PG8_WAIT_L(0); PG8_MMA(0, 0, At, B0); PG8_BAR; PG8_SCHED;
            PG8_LDB(B1, 1, 1); PG8_STAGE(PG8_SB(1, 0), b3, voffB);
            PG8_BAR; PG8_WAIT_L(0); PG8_MMA(0, 1, At, B1); PG8_BAR;
            PG8_LDA(At, 1, 1); PG8_STAGE(PG8_SA(1, 0), a3, voffA);
            PG8_BAR; PG8_WAIT_L(0); PG8_MMA(1, 0, At, B0); PG8_BAR; PG8_SCHED;
            PG8_STAGE(PG8_SB(1, 1), b3 + hstep, voffB);
            PG8_WAIT_V(6); PG8_BAR; PG8_MMA(1, 1, At, B1); PG8_BAR;
            }
        }
        if constexpr (ALIGN_EPI) { if (wr == 0) PG8_BAR; }
        if constexpr (!Epi::AFTER_DRAIN) { E(acc, cur, wr, wc, fr, fq); S.done(cur); }
        if (!has_next) break;
#pragma unroll
        for (int a = 0; a < 2; ++a)
#pragma unroll
            for (int b = 0; b < 2; ++b)
#pragma unroll
                for (int m = 0; m < 4; ++m)
#pragma unroll
                    for (int n = 0; n < 2; ++n) acc[a][b][m][n] = (f32x4){0.f, 0.f, 0.f, 0.f};
        cur = nxt; cA = nA; cB = nB; ++ui;
        if constexpr (ALIGN_EPI) { if (wr == 1) PG8_BAR; }
    }
    PG8_WAIT_V(0);
    if constexpr (!ALIGN_EPI) { if (wr == 0) PG8_BAR; }
    PG8_BAR;
    if constexpr (Epi::AFTER_DRAIN) { E.fused(acc, cur, wr, wc, fr, fq, lds, wid, lane); S.done(cur); }
#undef PG8_SA
#undef PG8_SB
#undef PG8_STAGE
#undef PG8_LDA
#undef PG8_LDB
#undef PG8_MMA
#undef PG8_WAIT_V
#undef PG8_WAIT_L
#undef PG8_BAR
#undef PG8_SCHED
}
}


typedef unsigned short bf16;
typedef unsigned v4u __attribute__((ext_vector_type(4)));
typedef float f32x4 __attribute__((ext_vector_type(4)));
typedef short bf16x8 __attribute__((ext_vector_type(8)));
typedef GAS unsigned gu32;
typedef GAS unsigned long long gu64;
#define RLX_AGENT __ATOMIC_RELAXED, __HIP_MEMORY_SCOPE_AGENT
#define LDS_WAIT() asm volatile("s_waitcnt lgkmcnt(0)" ::: "memory")
#define VM_WAIT() asm volatile("s_waitcnt vmcnt(0)" ::: "memory")
__device__ __forceinline__ unsigned long long rt() { return __builtin_amdgcn_s_memrealtime(); }
__device__ __forceinline__ unsigned f2bf(float f) { unsigned u = __builtin_bit_cast(unsigned, f); return (u + 0x7fffu + ((u >> 16) & 1u)) >> 16; }
__device__ __forceinline__ unsigned pk2(float lo, float hi) { return f2bf(lo) | (f2bf(hi) << 16); }

#define XB_TMO      128
#define XB_XCNT(j)  (256  + 64 * (j))
#define XB_XSUB(j)  (1280 + 64 * (j))
#define XB_XGEN(j)  (2304 + 64 * (j))
#define XB_TOP      3328
#define XB_TOPGEN   3392
#define XCD_BAR_WORDS 3456
#define XB_SPIN_CAP (1u << 18)

__device__ __forceinline__ unsigned xb_ld(unsigned* p)              { return __hip_atomic_load(p, __ATOMIC_RELAXED, __HIP_MEMORY_SCOPE_AGENT); }
__device__ __forceinline__ unsigned xb_add(unsigned* p, unsigned v) { return __hip_atomic_fetch_add(p, v, __ATOMIC_RELAXED, __HIP_MEMORY_SCOPE_AGENT); }
__device__ __forceinline__ unsigned xb_xcc_id() { return (unsigned)__builtin_amdgcn_s_getreg((3 << 11) | 20) & 0xFu; }
#define XB_SPIN(cond, bar) do { unsigned _sp = 0; while (cond) { __builtin_amdgcn_s_sleep(1); \
    if ((++_sp & 255u) == 0u) { if (xb_ld(&(bar)[XB_TMO])) break; if (_sp > XB_SPIN_CAP) { atomicAdd(&(bar)[XB_TMO], 1u); break; } } } } while (0)

struct XcdBarrier {
    unsigned* bar; unsigned x;
    volatile LAS unsigned* st;
};

__device__ __forceinline__ XcdBarrier xcd_barrier_post(unsigned* bar, volatile LAS unsigned* st) {
    XcdBarrier b; b.bar = bar; b.x = xb_xcc_id(); b.st = st;
    if (threadIdx.x == 0) (void)xb_add(&bar[XB_XCNT(b.x)], 1u);
    return b;
}
__device__ __forceinline__ void xcd_barrier_complete(unsigned* bar, unsigned x, unsigned& nloc, unsigned& nx) {
    const unsigned G = gridDim.x * gridDim.y * gridDim.z;
    unsigned sum, cnt, mine, sp = 0u;
    for (;;) {
        sum = 0u; cnt = 0u; mine = 0u;
#pragma unroll
        for (unsigned j = 0; j < 16; ++j) { const unsigned c = xb_ld(&bar[XB_XCNT(j)]); sum += c; cnt += (c > 0u) ? 1u : 0u; mine = (j == x) ? c : mine; }
        if (sum == G) break;
        __builtin_amdgcn_s_sleep(1);
        if ((++sp & 255u) == 0u) { if (xb_ld(&bar[XB_TMO])) break; if (sp > XB_SPIN_CAP) { atomicAdd(&bar[XB_TMO], 1u); break; } }
    }
    nloc = mine > 0u ? mine : 1u; nx = cnt > 0u ? cnt : 1u;
}

__device__ __forceinline__ void xcd_barrier(const XcdBarrier& b) {
    asm volatile("s_waitcnt vmcnt(0)" ::: "memory");
    __syncthreads();
    if (threadIdx.x == 0) {
        unsigned* bar = b.bar;
        __builtin_amdgcn_s_waitcnt(0);
        unsigned nloc = b.st[0], nx = b.st[1];
        if (nloc == 0u) { xcd_barrier_complete(bar, b.x, nloc, nx); b.st[0] = nloc; b.st[1] = nx; }
        const unsigned old = xb_add(&bar[XB_XSUB(b.x)], 1u);
        const unsigned gen = old / nloc;
        if (old + 1u == (gen + 1u) * nloc) {
            __builtin_amdgcn_fence(__ATOMIC_RELEASE, "agent");
            asm volatile("s_waitcnt vmcnt(0)" ::: "memory");
            const unsigned og = xb_add(&bar[XB_TOP], 1u);
            const unsigned tg = og / nx;
            if (og + 1u == (tg + 1u) * nx) xb_add(&bar[XB_TOPGEN], 1u);
            else XB_SPIN(xb_ld(&bar[XB_TOPGEN]) == tg, bar);
            __builtin_amdgcn_fence(__ATOMIC_ACQUIRE, "agent");
            xb_add(&bar[XB_XGEN(b.x)], 1u);
            asm volatile("s_waitcnt vmcnt(0)" ::: "memory");
        } else {
            XB_SPIN(xb_ld(&bar[XB_XGEN(b.x)]) == gen, bar);
            __builtin_amdgcn_fence(__ATOMIC_ACQUIRE, "agent");
            asm volatile("s_waitcnt vmcnt(0)" ::: "memory");
        }
    }
    __syncthreads();
}
typedef pg8::u32x4 u32x4;
typedef unsigned u32x2 __attribute__((ext_vector_type(2)));
constexpr int D = 1024, SEQ = 8192, MP = 16384, MS = 128, MT = MP + MS, MPAD = 16640;
constexpr int DFF = 2816, NFF2 = 2 * DFF, NCOND = 130, ADAW = 6 * D;
constexpr float EPSF = 1e-6f;
constexpr size_t OY_P = 0, OY_S = 16777216, OST_P = 16908288, OST_S = 17432576, OCK_P = 50987008, OCV_P = 51052544, OCK_S = 51118080, OCV_S = 55312384, OUT_TOTAL = 59506688;

__device__ __forceinline__ unsigned cvt_pk(float lo, float hi) { unsigned r; asm volatile("v_cvt_pk_bf16_f32 %0, %1, %2" : "=v"(r) : "v"(lo), "v"(hi)); return r; }
__device__ __forceinline__ float bf2f(unsigned short u) { return __uint_as_float((unsigned)u << 16); }
__device__ __forceinline__ float silu_f(float x) { return x / (1.0f + __expf(-x)); }
__device__ __forceinline__ float sigmoid_f(float x) { return 1.0f / (1.0f + __expf(-x)); }
__device__ __forceinline__ int cond_of(int row) { return row < MP ? 128 + (row >> 13) : ((row - MP) < MS ? (row - MP) : MS - 1); }

constexpr size_t MiB = 1u << 20;
constexpr size_t WS_CTL = 0, CTL_ZERO_BYTES = 1 * MiB;
constexpr size_t WS_WIN = 1 * MiB, WS_WOA = 17 * MiB, WS_WKV = 21 * MiB, WS_WQ = 22 * MiB, WS_WOB = 26 * MiB, WS_WF1 = 30 * MiB, WS_WF2 = 74 * MiB;
constexpr size_t WS_ADA = 96 * MiB, WS_ADAKV = 109 * MiB;
constexpr size_t WS_SCAN = 111 * MiB, WS_DLOG = 127 * MiB;
constexpr size_t WS_H = 128 * MiB;
constexpr size_t WS_XN = 193 * MiB, WS_OG = 226 * MiB;
constexpr size_t WS_KSH = 259 * MiB, WS_VSH = 268 * MiB;
constexpr size_t WS_QH = 277 * MiB, WS_LF = 310 * MiB, WS_VH = 375 * MiB, WS_GH = 408 * MiB;
constexpr size_t WS_ACT = 277 * MiB;
constexpr size_t WS_XNKV = 408 * MiB;
constexpr size_t WS_END = 441 * MiB;
static_assert(WS_ACT + (size_t)MPAD * DFF * 2 <= WS_VH && WS_H + (size_t)MPAD * D * 4 <= WS_XN && WS_ADA + (size_t)4 * NCOND * ADAW * 4 <= WS_ADAKV, "d_ws map");
constexpr int CW_BAR = 4096;
constexpr int WIN_SZ = 4096 * 1024, WOA_SZ = 1024 * 1024, WF1_SZ = NFF2 * 1024, WF2_SZ = 1024 * DFF;
constexpr int RING_OFF = 0, RING_BYTES = 131072, LDSCTL_OFF = RING_BYTES, MISC_OFF = LDSCTL_OFF + 320, LDS_BYTES = 147456;
constexpr int NWAVES = 8;
#define EPI_LOOP_BEGIN \
    _Pragma("unroll") for (int ai = 0; ai < 2; ++ai) _Pragma("unroll") for (int m = 0; m < 4; ++m) { const int row = u.pm * 256 + ai * 128 + wr * 64 + m * 16 + fr; \
    _Pragma("unroll") for (int bj = 0; bj < 2; ++bj) { const int ct = bj * 128 + wc * 32 + 8 * fq; const f32x4 v0 = acc[ai][bj][m][0], v1 = acc[ai][bj][m][1];
#define EPI_LOOP_END } }

struct EpiInProj {
    static constexpr bool PERM = true, AFTER_DRAIN = false;
    GAS unsigned char* ws; const GAS float* lb0; const GAS float* lb1; int layer;
    __device__ __forceinline__ void operator()(const f32x4 (&acc)[2][2][4][2], const pg8::Unit& u, int wr, int wc, int fr, int fq) const {
        const int kind = u.pn >> 2, cb = (u.pn & 3) * 256;
        EPI_LOOP_BEGIN
            const int c = cb + ct; const size_t off = (size_t)row * D + c;
            if (kind == 1) {
                f32x4 o0, o1;
#pragma unroll
                for (int j = 0; j < 4; ++j) {
                    float lba = 0.f, lbb = 0.f;
                    if (layer == 1) { lba = sigmoid_f(lb1[c + j] - lb0[c + j]); lbb = sigmoid_f(lb1[c + 4 + j] - lb0[c + 4 + j]); }
                    const float fa = lba + (1.0f - lba) * sigmoid_f(v0[j]), fb = lbb + (1.0f - lbb) * sigmoid_f(v1[j]);
                    o0[j] = logf(fmaxf(fa, 1e-30f)); o1[j] = logf(fmaxf(fb, 1e-30f));
                }
                GAS float* LF = (GAS float*)(ws + WS_LF); *(GAS f32x4*)(LF + off) = o0; *(GAS f32x4*)(LF + off + 4) = o1;
            } else {
                f32x4 a = v0, b = v1;
                if (kind != 2) {
#pragma unroll
                    for (int j = 0; j < 4; ++j) { a[j] = silu_f(a[j]); b[j] = silu_f(b[j]); }
                }
                u32x4 w; w.x = cvt_pk(a[0], a[1]); w.y = cvt_pk(a[2], a[3]); w.z = cvt_pk(b[0], b[1]); w.w = cvt_pk(b[2], b[3]);
                const size_t ob = kind == 0 ? WS_QH : (kind == 2 ? WS_VH : WS_GH); GAS bf16* dst = (GAS bf16*)(ws + ob);
                *(GAS u32x4*)(dst + off) = w;
            }
        EPI_LOOP_END
    }
};
struct EpiRes {
    static constexpr bool PERM = true, AFTER_DRAIN = false;
    GAS float* H; const GAS float* gate;
    __device__ __forceinline__ void operator()(const f32x4 (&acc)[2][2][4][2], const pg8::Unit& u, int wr, int wc, int fr, int fq) const {
        const int c0 = u.pn * 256 + wc * 32 + 8 * fq;
        const bool uni = u.pm < MP / 256;
        f32x4 gu[2][2];
        { const GAS float* gp = gate + (size_t)cond_of(u.pm * 256) * ADAW + c0;
#pragma unroll
          for (int bj = 0; bj < 2; ++bj) { gu[bj][0] = *(const GAS f32x4*)(gp + bj * 128); gu[bj][1] = *(const GAS f32x4*)(gp + bj * 128 + 4); } }
#pragma unroll
        for (int am = 0; am < 4; ++am) { const int ai = am >> 1, m0 = (am & 1) * 2;
            f32x4 hv[4][2][2];
#pragma unroll
            for (int m = m0; m < m0 + 2; ++m) { const int row = u.pm * 256 + ai * 128 + wr * 64 + m * 16 + fr; const GAS float* hp = H + (size_t)row * D + c0;
#pragma unroll
                for (int bj = 0; bj < 2; ++bj) { hv[m][bj][0] = *(const GAS f32x4*)(hp + bj * 128); hv[m][bj][1] = *(const GAS f32x4*)(hp + bj * 128 + 4); } }
#pragma unroll
            for (int m = m0; m < m0 + 2; ++m) { const int row = u.pm * 256 + ai * 128 + wr * 64 + m * 16 + fr; GAS float* hp = H + (size_t)row * D + c0;
                f32x4 g[2][2];
                if (uni) {
#pragma unroll
                    for (int bj = 0; bj < 2; ++bj) { g[bj][0] = gu[bj][0]; g[bj][1] = gu[bj][1]; }
                } else { const GAS float* gp = gate + (size_t)cond_of(row) * ADAW + c0;
#pragma unroll
                    for (int bj = 0; bj < 2; ++bj) { g[bj][0] = *(const GAS f32x4*)(gp + bj * 128); g[bj][1] = *(const GAS f32x4*)(gp + bj * 128 + 4); } }
#pragma unroll
                for (int bj = 0; bj < 2; ++bj) { *(GAS f32x4*)(hp + bj * 128) = hv[m][bj][0] + g[bj][0] * acc[ai][bj][m][0]; *(GAS f32x4*)(hp + bj * 128 + 4) = hv[m][bj][1] + g[bj][1] * acc[ai][bj][m][1]; } }
        }
    }
};
struct EpiSwiGLU {
    static constexpr bool PERM = true, AFTER_DRAIN = false;
    GAS bf16* ACT;
    __device__ __forceinline__ void operator()(const f32x4 (&acc)[2][2][4][2], const pg8::Unit& u, int wr, int wc, int fr, int fq) const {
        EPI_LOOP_BEGIN
            const int oc = (u.pn * 256 + ct) >> 1;
            u32x2 w; w.x = cvt_pk(silu_f(v0[0]) * v1[0], silu_f(v0[1]) * v1[1]); w.y = cvt_pk(silu_f(v0[2]) * v1[2], silu_f(v0[3]) * v1[3]);
            *(GAS u32x2*)(ACT + (size_t)row * DFF + oc) = w;
        EPI_LOOP_END
    }
};
struct EpiKV {
    static constexpr bool PERM = true, AFTER_DRAIN = false;
    GAS bf16* KSH; GAS bf16* VSH; GAS float* out;
    __device__ __forceinline__ void operator()(const f32x4 (&acc)[2][2][4][2], const pg8::Unit& u, int wr, int wc, int fr, int fq) const {
        GAS bf16* dst = u.pn == 0 ? KSH : VSH;
        EPI_LOOP_BEGIN
            const int c = ct;
            u32x4 w; w.x = cvt_pk(v0[0], v0[1]); w.y = cvt_pk(v0[2], v0[3]); w.z = cvt_pk(v1[0], v1[1]); w.w = cvt_pk(v1[2], v1[3]);
            *(GAS u32x4*)(dst + (size_t)row * 256 + c) = w;
            GAS float* o = nullptr;
            if (row < MP) { const int t = row & (SEQ - 1), b = row >> 13; if (t >= SEQ - 128) o = out + (u.pn == 0 ? OCK_P : OCV_P) + ((size_t)(b * 128 + (t - (SEQ - 128))) * 256 + c); }
            else if (row < MT) { o = out + (u.pn == 0 ? OCK_S : OCV_S) + ((size_t)((row - MP) * 128 + 127) * 256 + c); }
            if (o) { *(GAS f32x4*)o = v0; *(GAS f32x4*)(o + 4) = v1; }
        EPI_LOOP_END
    }
};
struct EpiQ {
    static constexpr bool PERM = true, AFTER_DRAIN = false;
    GAS bf16* Q;
    __device__ __forceinline__ void operator()(const f32x4 (&acc)[2][2][4][2], const pg8::Unit& u, int wr, int wc, int fr, int fq) const {
        EPI_LOOP_BEGIN
            const int c = u.pn * 256 + ct;
            u32x4 w; w.x = cvt_pk(v0[0] * 0.125f, v0[1] * 0.125f); w.y = cvt_pk(v0[2] * 0.125f, v0[3] * 0.125f); w.z = cvt_pk(v1[0] * 0.125f, v1[1] * 0.125f); w.w = cvt_pk(v1[2] * 0.125f, v1[3] * 0.125f);
            *(GAS u32x4*)(Q + (size_t)row * D + c) = w;
        EPI_LOOP_END
    }
};
template <int KS, class SEpi>
__device__ __forceinline__ void skinny_gemm(const GAS bf16* A, const GAS bf16* Bt, int N, int K, const SEpi& E, LAS unsigned char* lds, int vcu, int G, int wave, int lane) {
    const int r = lane & 15, g = lane >> 4, nitems = (N / 16) * (KS == 4 ? 4 : 1), ksteps = K / (32 * KS);
    LAS f32x4* red = (LAS f32x4*)lds;
    for (int it = vcu; it < nitems; it += G) {
        const int nt = KS == 4 ? (it >> 2) : it, mt = KS == 4 ? 2 * (it & 3) + (wave >> 2) : wave, kq = KS == 4 ? (wave & 3) : 0;
        const GAS bf16* ap = A + (size_t)(mt * 16 + r) * K + (size_t)kq * (K / KS) + 8 * g;
        const GAS bf16* bp = Bt + (size_t)(nt * 16 + r) * K + (size_t)kq * (K / KS) + 8 * g;
        f32x4 acc = (f32x4){0.f, 0.f, 0.f, 0.f};
#pragma unroll 8
        for (int s = 0; s < ksteps; ++s) {
            const bf16x8 af = __builtin_bit_cast(bf16x8, *(const GAS u32x4*)(ap + 32 * s)), bf = __builtin_bit_cast(bf16x8, *(const GAS u32x4*)(bp + 32 * s));
            acc = __builtin_amdgcn_mfma_f32_16x16x32_bf16(bf, af, acc, 0, 0, 0);
        }
        if (KS == 4) {
            red[wave * 64 + lane] = acc; __syncthreads();
            if ((wave & 3) == 0) acc = (red[wave * 64 + lane] + red[(wave + 1) * 64 + lane]) + (red[(wave + 2) * 64 + lane] + red[(wave + 3) * 64 + lane]);
        }
        const bool owner = KS == 4 ? (wave & 3) == 0 : true;
        E(MP + mt * 16 + r, nt * 16 + 4 * g, acc, owner);
        if (KS == 4) __syncthreads();
    }
}
struct SEpiInProj {
    GAS unsigned char* ws; const GAS float* lb0; const GAS float* lb1; int layer;
    __device__ __forceinline__ void operator()(int row, int col, f32x4 v, bool owner) const {
        if (!owner) return;
        const int kind = col >> 10, c = col & 1023; const size_t off = (size_t)row * D + c;
        if (kind == 1) { f32x4 o;
#pragma unroll
            for (int j = 0; j < 4; ++j) { float lb = 0.f; if (layer == 1) lb = sigmoid_f(lb1[c + j] - lb0[c + j]);
                o[j] = logf(fmaxf(lb + (1.0f - lb) * sigmoid_f(v[j]), 1e-30f)); }
            *(GAS f32x4*)((GAS float*)(ws + WS_LF) + off) = o;
        } else {
            if (kind != 2) {
#pragma unroll
                for (int j = 0; j < 4; ++j) v[j] = silu_f(v[j]);
            }
            u32x2 w; w.x = cvt_pk(v[0], v[1]); w.y = cvt_pk(v[2], v[3]);
            const size_t ob = kind == 0 ? WS_QH : (kind == 2 ? WS_VH : WS_GH);
            *(GAS u32x2*)((GAS bf16*)(ws + ob) + off) = w;
        }
    }
};
struct SEpiRes {
    GAS float* H; const GAS float* gate;
    __device__ __forceinline__ void operator()(int row, int col, f32x4 v, bool owner) const {
        if (!owner) return;
        const f32x4 g = *(const GAS f32x4*)(gate + (size_t)cond_of(row) * ADAW + col);
        GAS f32x4* hp = (GAS f32x4*)(H + (size_t)row * D + col); *hp = *hp + g * v;
    }
};
struct SEpiSwiGLU {
    GAS bf16* ACT;
    __device__ __forceinline__ void operator()(int row, int col, f32x4 v, bool owner) const {
        f32x4 up;
#pragma unroll
        for (int j = 0; j < 4; ++j) up[j] = __shfl_xor(v[j], 16);
        if (!owner || ((col >> 2) & 1)) return;
        u32x2 w; w.x = cvt_pk(silu_f(v[0]) * up[0], silu_f(v[1]) * up[1]); w.y = cvt_pk(silu_f(v[2]) * up[2], silu_f(v[3]) * up[3]);
        *(GAS u32x2*)(ACT + (size_t)row * DFF + (col >> 1)) = w;
    }
};
struct SEpiKV {
    GAS bf16* KSH; GAS bf16* VSH; GAS float* out;
    __device__ __forceinline__ void operator()(int row, int col, f32x4 v, bool owner) const {
        if (!owner) return;
        const int isv = col >> 8, c = col & 255;
        u32x2 w; w.x = cvt_pk(v[0], v[1]); w.y = cvt_pk(v[2], v[3]);
        *(GAS u32x2*)((isv ? VSH : KSH) + (size_t)row * 256 + c) = w;
        *(GAS f32x4*)(out + (isv ? OCV_S : OCK_S) + ((size_t)((row - MP) * 128 + 127) * 256 + c)) = v;
    }
};
struct SEpiQ {
    GAS bf16* Q;
    __device__ __forceinline__ void operator()(int row, int col, f32x4 v, bool owner) const {
        if (!owner) return;
        u32x2 w; w.x = cvt_pk(v[0] * 0.125f, v[1] * 0.125f); w.y = cvt_pk(v[2] * 0.125f, v[3] * 0.125f);
        *(GAS u32x2*)(Q + (size_t)row * D + col) = w;
    }
};
struct Args { const GAS float* in[25]; GAS float* out; GAS unsigned char* ws; };
constexpr int PTAB_OFF = LDSCTL_OFF + 1024;
__device__ __forceinline__ unsigned long long ldptr(volatile LAS unsigned long long* tab, int i) {
    const unsigned long long v = tab[i];
    const unsigned lo = __builtin_amdgcn_readfirstlane((unsigned)v), hi = __builtin_amdgcn_readfirstlane((unsigned)(v >> 32));
    return ((unsigned long long)hi << 32) | lo;
}
#define PTF(i) ((const GAS float*)ldptr(PT, (i)))
enum { I_XP = 0, I_XS, I_STATE, I_CK, I_CV, I_CP, I_CS, I_WIN, I_WOA, I_GNORM, I_LB, I_WKV, I_WADAKV, I_BADAKV, I_KVNORM, I_WQ, I_WOB, I_SINKS, I_RELB, I_NORMW, I_WADA, I_BADA, I_WF1, I_WF2, I_FNORM };

__device__ __forceinline__ float wave_sum(float v) {
#pragma unroll
    for (int o = 1; o < 64; o <<= 1) v += __shfl_xor(v, o);
    return v;
}
__device__ __forceinline__ float wave_max(float v) {
#pragma unroll
    for (int o = 1; o < 64; o <<= 1) v = fmaxf(v, __shfl_xor(v, o));
    return v;
}
__device__ __forceinline__ void transpose_item(const GAS float* W, int K, int N, GAS bf16* WT, int mode, LAS float* scr, int item, int lane) {
    const int nblk = N / 32, kb = item / nblk, nb = item % nblk, k0 = 64 * kb, n0 = 32 * nb;
#pragma unroll 8
    for (int i = 0; i < 32; ++i) { const int kk = 2 * i + (lane >> 5); scr[kk * 33 + (lane & 31)] = W[(size_t)(k0 + kk) * N + n0 + (lane & 31)]; }
    LDS_WAIT(); asm volatile("" ::: "memory");
    const int c = lane & 7;
#pragma unroll
    for (int j = 0; j < 4; ++j) { const int n = (lane >> 3) + 8 * j; const LAS float* s = scr + (8 * c) * 33 + n;
        v4u o; o.x = pk2(s[0 * 33], s[1 * 33]); o.y = pk2(s[2 * 33], s[3 * 33]); o.z = pk2(s[4 * 33], s[5 * 33]); o.w = pk2(s[6 * 33], s[7 * 33]);
        const int gn = n0 + n; int drow = gn;
        if (mode == 1) { const int up = gn >= DFF ? 1 : 0; const int jn = up ? gn - DFF : gn; drow = 8 * (jn >> 2) + (jn & 3) + 4 * up; }
        *(GAS v4u*)(WT + (size_t)drow * K + k0 + 8 * c) = o; }
    LDS_WAIT(); asm volatile("" ::: "memory");
}
__device__ __forceinline__ void p0_transposes(volatile LAS unsigned long long* PT, LAS unsigned char* lds, int gw, int NGW, int wave, int lane) {
    LAS float* scr = (LAS float*)(lds + RING_OFF + 16384 + wave * 12288);
    GAS unsigned char* ws = (GAS unsigned char*)ldptr(PT, 26);
    constexpr int I_IN = 16 * 128, I_SQ = 16 * 32, I_KV = 16 * 16, I_F1 = 16 * (NFF2 / 32), I_F2 = (DFF / 64) * 32;
    constexpr int TOTAL = 2 * I_IN + 2 * I_SQ + I_KV + 2 * I_SQ + 2 * I_SQ + 4 * I_F1 + 4 * I_F2;
    for (int it = gw; it < TOTAL; it += NGW) {
        int r = it; const GAS float* W; GAS bf16* WT; int K = D, N = D, mode = 0, item;
        if (r < 4 * I_F1) { const int l = r / I_F1; W = PTF(I_WF1) + (size_t)l * D * NFF2; N = NFF2; WT = (GAS bf16*)(ws + WS_WF1) + (size_t)l * WF1_SZ; mode = 1; item = r % I_F1; }
        else if ((r -= 4 * I_F1) < 4 * I_F2) { const int l = r / I_F2; W = PTF(I_WF2) + (size_t)l * DFF * D; K = DFF; WT = (GAS bf16*)(ws + WS_WF2) + (size_t)l * WF2_SZ; item = r % I_F2; }
        else if ((r -= 4 * I_F2) < 2 * I_IN) { const int l = r / I_IN; W = PTF(I_WIN) + (size_t)l * D * 4096; N = 4096; WT = (GAS bf16*)(ws + WS_WIN) + (size_t)l * WIN_SZ; item = r % I_IN; }
        else if ((r -= 2 * I_IN) < 2 * I_SQ) { const int l = r / I_SQ; W = PTF(I_WOA) + (size_t)l * D * D; WT = (GAS bf16*)(ws + WS_WOA) + (size_t)l * WOA_SZ; item = r % I_SQ; }
        else if ((r -= 2 * I_SQ) < 2 * I_SQ) { const int l = r / I_SQ; W = PTF(I_WQ) + (size_t)l * D * D; WT = (GAS bf16*)(ws + WS_WQ) + (size_t)l * WOA_SZ; item = r % I_SQ; }
        else if ((r -= 2 * I_SQ) < 2 * I_SQ) { const int l = r / I_SQ; W = PTF(I_WOB) + (size_t)l * D * D; WT = (GAS bf16*)(ws + WS_WOB) + (size_t)l * WOA_SZ; item = r % I_SQ; }
        else { r -= 2 * I_SQ; W = PTF(I_WKV); N = 512; WT = (GAS bf16*)(ws + WS_WKV); item = r; }
        transpose_item(W, K, N, WT, mode, scr, item, lane);
    }
}
__device__ __forceinline__ bf16x8 silu8_bf16(const GAS float* p) {
    const f32x4 x0 = *(const GAS f32x4*)p, x1 = *(const GAS f32x4*)(p + 4);
    u32x4 w; w.x = cvt_pk(silu_f(x0[0]), silu_f(x0[1])); w.y = cvt_pk(silu_f(x0[2]), silu_f(x0[3])); w.z = cvt_pk(silu_f(x1[0]), silu_f(x1[1])); w.w = cvt_pk(silu_f(x1[2]), silu_f(x1[3]));
    return __builtin_bit_cast(bf16x8, w);
}
__device__ __forceinline__ void ada_item(const GAS float* W, int ldw, int n0, const GAS float* bias, const GAS float* c_s, const GAS float* c_p, GAS float* outp, int ldo, LAS unsigned char* lds, int tid, int wave, int lane) {
    LAS bf16* Wt = (LAS bf16*)lds;
    const int kk = tid >> 4, n4 = tid & 15, r = lane & 15, g = lane >> 4;
    f32x4 acc[4], acc9[4];
#pragma unroll
    for (int q = 0; q < 4; ++q) { acc[q] = (f32x4){0.f, 0.f, 0.f, 0.f}; acc9[q] = (f32x4){0.f, 0.f, 0.f, 0.f}; }
    f32x4 wreg = *(const GAS f32x4*)(W + (size_t)kk * ldw + n0 + 4 * n4);
    for (int ks = 0; ks < 32; ++ks) {
        const int buf = ks & 1;
#pragma unroll
        for (int j = 0; j < 4; ++j) Wt[(buf * 64 + 4 * n4 + j) * 40 + kk] = (bf16)f2bf(wreg[j]);
        __syncthreads();
        if (ks + 1 < 32) wreg = *(const GAS f32x4*)(W + (size_t)((ks + 1) * 32 + kk) * ldw + n0 + 4 * n4);
        const bf16x8 af = silu8_bf16(c_s + (size_t)(16 * wave + r) * D + 32 * ks + 8 * g);
        bf16x8 bfr[4];
#pragma unroll
        for (int q = 0; q < 4; ++q) bfr[q] = *(const LAS bf16x8*)(Wt + (buf * 64 + 16 * q + r) * 40 + 8 * g);
#pragma unroll
        for (int q = 0; q < 4; ++q) acc[q] = __builtin_amdgcn_mfma_f32_16x16x32_bf16(af, bfr[q], acc[q], 0, 0, 0);
        if (wave == 0) {
            bf16x8 a9 = (bf16x8){0, 0, 0, 0, 0, 0, 0, 0};
            if (r < 2) a9 = silu8_bf16(c_p + (size_t)r * D + 32 * ks + 8 * g);
#pragma unroll
            for (int q = 0; q < 4; ++q) acc9[q] = __builtin_amdgcn_mfma_f32_16x16x32_bf16(a9, bfr[q], acc9[q], 0, 0, 0);
        }
    }
#pragma unroll
    for (int q = 0; q < 4; ++q) { const int n = n0 + 16 * q + r; const float bv = bias[n];
#pragma unroll
        for (int rg = 0; rg < 4; ++rg) { outp[(size_t)(16 * wave + 4 * g + rg) * ldo + n] = acc[q][rg] + bv;
            if (wave == 0 && g == 0 && rg < 2) outp[(size_t)(128 + rg) * ldo + n] = acc9[q][rg] + bv; } }
    __syncthreads();
}
__device__ __forceinline__ void p0_ada(volatile LAS unsigned long long* PT, LAS unsigned char* lds, int vcu, int G, int tid, int wave, int lane) {
    GAS unsigned char* ws = (GAS unsigned char*)ldptr(PT, 26);
    constexpr int PER_L = ADAW / 64, NIT = 4 * PER_L + 2048 / 64;
    for (int it = vcu; it < NIT; it += G) {
        if (it < 4 * PER_L) { const int l = it / PER_L, nb = it % PER_L;
            ada_item(PTF(I_WADA) + (size_t)l * D * ADAW, ADAW, 64 * nb, PTF(I_BADA) + (size_t)l * ADAW, PTF(I_CS), PTF(I_CP), (GAS float*)(ws + WS_ADA) + (size_t)l * NCOND * ADAW, ADAW, lds, tid, wave, lane); }
        else { const int nb = it - 4 * PER_L;
            ada_item(PTF(I_WADAKV), 2048, 64 * nb, PTF(I_BADAKV), PTF(I_CS), PTF(I_CP), (GAS float*)(ws + WS_ADAKV), 2048, lds, tid, wave, lane); }
    }
}
template <int MODE>
__device__ __forceinline__ void norm_pass(int gw, int NGW, int lane, const GAS float* H, const GAS float* xp, const GAS float* xs, GAS float* Hc,
                                          const GAS float* nw, const GAS float* sh, const GAS float* sc, int ldc, GAS bf16* XN,
                                          const GAS float* nw2, const GAS float* sh2, const GAS float* sc2, int ldc2, GAS bf16* XN2, GAS float* out) {
    for (int row = gw; row < MT; row += NGW) {
        const GAS float* src = MODE == 1 ? (row < MP ? xp + (size_t)row * D : xs + (size_t)(row - MP) * D) : H + (size_t)row * D;
        f32x4 v[4]; float ss = 0.f;
#pragma unroll
        for (int j = 0; j < 4; ++j) { v[j] = *(const GAS f32x4*)(src + 4 * lane + 256 * j); ss += (v[j][0] * v[j][0] + v[j][1] * v[j][1]) + (v[j][2] * v[j][2] + v[j][3] * v[j][3]); }
        const float rstd = 1.0f / sqrtf(wave_sum(ss) * (1.0f / D) + EPSF);
        const int ci = cond_of(row);
#pragma unroll
        for (int j = 0; j < 4; ++j) {
            const int c = 4 * lane + 256 * j;
            if (MODE == 1) *(GAS f32x4*)(Hc + (size_t)row * D + c) = v[j];
            if (MODE == 3) {
                const f32x4 w = *(const GAS f32x4*)(nw + c);
                GAS float* o = row < MP ? out + OY_P + (size_t)row * D + c : out + OY_S + (size_t)(row - MP) * D + c;
                *(GAS f32x4*)o = v[j] * rstd * w;
            } else {
                const f32x4 w = *(const GAS f32x4*)(nw + c), s1 = *(const GAS f32x4*)(sc + (size_t)ci * ldc + c), b1 = *(const GAS f32x4*)(sh + (size_t)ci * ldc + c);
                const f32x4 y = (v[j] * rstd * w) * (1.0f + s1) + b1;
                u32x2 p; p.x = cvt_pk(y[0], y[1]); p.y = cvt_pk(y[2], y[3]);
                *(GAS u32x2*)(XN + (size_t)row * D + c) = p;
                if (MODE == 2) {
                    const f32x4 w2 = *(const GAS f32x4*)(nw2 + c), s2 = *(const GAS f32x4*)(sc2 + (size_t)ci * ldc2 + c), b2 = *(const GAS f32x4*)(sh2 + (size_t)ci * ldc2 + c);
                    const f32x4 y2 = (v[j] * rstd * w2) * (1.0f + s2) + b2;
                    u32x2 p2; p2.x = cvt_pk(y2[0], y2[1]); p2.y = cvt_pk(y2[2], y2[3]);
                    *(GAS u32x2*)(XN2 + (size_t)row * D + c) = p2;
                }
            }
        }
    }
}
constexpr int SCT = 512, NSC = SEQ / SCT, TT = 32, NUNIT = 2 * 8 * NSC;
template <bool PASS_C>
__device__ __forceinline__ void scan_unit(int unit, const GAS bf16* QH, const GAS float* LF, const GAS bf16* VH, const GAS bf16* GH, GAS float* U, GAS float* DLOG, GAS bf16* OG, const GAS float* gnorm,
                                          LAS unsigned char* lds, int tid, int wave, int lane) {
    LAS float* Ft = (LAS float*)lds; LAS float* Qt = Ft + TT * 128; LAS float* Vt = Qt + TT * 128; LAS float* Ot = Vt + TT * 128;
    const int b = unit >> 7, h = (unit >> 4) & 7, sc = unit & 15, row0 = b * SEQ + sc * SCT, col0 = h * 128;
    const int vloc = lane & 15, kp = lane >> 4, v = 16 * wave + vloc;
    float s[32];
#pragma unroll
    for (int i = 0; i < 32; ++i) s[i] = PASS_C ? U[(size_t)unit * 16384 + (32 * kp + i) * 128 + v] : 0.f;
    const int sk = tid & 127, sq = tid >> 7;
    float slf = 0.f;
    for (int tile = 0; tile < SCT / TT; ++tile) {
        const int rowt = row0 + tile * TT;
#pragma unroll
        for (int j = 0; j < TT / 4; ++j) { const int t = sq + 4 * j; const size_t go = (size_t)(rowt + t) * D + col0 + sk;
            const float lf = LF[go]; Ft[t * 128 + sk] = __expf(lf); slf += lf;
            Vt[t * 128 + sk] = bf2f(VH[go]); if (PASS_C) Qt[t * 128 + sk] = bf2f(QH[go]); }
        __syncthreads();
        for (int t = 0; t < TT; ++t) {
            const float vv = Vt[t * 128 + v]; float acc = 0.f;
#pragma unroll
            for (int i4 = 0; i4 < 8; ++i4) {
                const f32x4 f = *(const LAS f32x4*)(Ft + t * 128 + 32 * kp + 4 * i4);
                f32x4 q = (f32x4){0.f, 0.f, 0.f, 0.f}; if (PASS_C) q = *(const LAS f32x4*)(Qt + t * 128 + 32 * kp + 4 * i4);
#pragma unroll
                for (int e = 0; e < 4; ++e) { const float sn = f[e] * (s[4 * i4 + e] - vv) + vv; s[4 * i4 + e] = sn; if (PASS_C) acc += q[e] * sn; }
            }
            if (PASS_C) { acc += __shfl_xor(acc, 16); acc += __shfl_xor(acc, 32); if (kp == 0) Ot[t * 128 + v] = acc; }
        }
        if (PASS_C) {
            __syncthreads();
#pragma unroll
            for (int r = 0; r < 4; ++r) { const int t = 4 * wave + r; const float x0 = Ot[t * 128 + lane], x1 = Ot[t * 128 + 64 + lane];
                const float rs = 1.0f / sqrtf(wave_sum(x0 * x0 + x1 * x1) * (1.0f / 128.0f) + EPSF);
                const size_t go = (size_t)(rowt + t) * D + col0 + lane;
                OG[go] = (bf16)f2bf(x0 * rs * gnorm[lane] * bf2f(GH[go])); OG[go + 64] = (bf16)f2bf(x1 * rs * gnorm[64 + lane] * bf2f(GH[go + 64])); }
        }
        __syncthreads();
    }
    if (!PASS_C) {
#pragma unroll
        for (int i = 0; i < 32; ++i) U[(size_t)unit * 16384 + (32 * kp + i) * 128 + v] = s[i];
        Ft[sq * 128 + sk] = slf; __syncthreads();
        if (tid < 128) DLOG[unit * 128 + tid] = (Ft[tid] + Ft[128 + tid]) + (Ft[256 + tid] + Ft[384 + tid]);
        __syncthreads();
    }
}
__device__ __forceinline__ void scan_combine(int layer, GAS float* U, const GAS float* DLOG, GAS float* out, int gt, int NGT) {
    for (int e = gt; e < 16 * 16384; e += NGT) {
        const int bh = e >> 14, idx = e & 16383, k = idx >> 7;
        float uv[NSC], dv[NSC];
#pragma unroll
        for (int sc = 0; sc < NSC; ++sc) { uv[sc] = U[(size_t)(bh * NSC + sc) * 16384 + idx]; dv[sc] = DLOG[(bh * NSC + sc) * 128 + k]; }
        float S = 0.f;
#pragma unroll
        for (int sc = 0; sc < NSC; ++sc) { U[(size_t)(bh * NSC + sc) * 16384 + idx] = S; S = __expf(dv[sc]) * S + uv[sc]; }
        const int b = bh >> 3, h = bh & 7;
        out[OST_P + (size_t)((b * 2 + layer) * 8 + h) * 16384 + idx] = S;
    }
}
__device__ __forceinline__ void scan_sample_unit(int su, int layer, const GAS bf16* QH, const GAS float* LF, const GAS bf16* VH, const GAS bf16* GH, const GAS float* S0g, GAS float* out, GAS bf16* OG, const GAS float* gnorm,
                                                 LAS unsigned char* lds, int tid, int wave, int lane) {
    LAS float* red = (LAS float*)lds; LAS float* Ot = red + 512;
    const int b = su >> 3, h = su & 7, row = MP + b, col0 = h * 128, v = tid & 127, kq = tid >> 7;
    const size_t so = (size_t)((b * 2 + layer) * 8 + h) * 16384;
    const GAS float* S0 = S0g + so; GAS float* S1 = out + OST_S + so;
    const float vv = bf2f(VH[(size_t)row * D + col0 + v]); float acc = 0.f;
#pragma unroll 8
    for (int i = 0; i < 32; ++i) { const int k = 32 * kq + i; const size_t go = (size_t)row * D + col0 + k;
        const float f = __expf(LF[go]), q = bf2f(QH[go]);
        const float sn = f * (S0[k * 128 + v] - vv) + vv; S1[k * 128 + v] = sn; acc += q * sn; }
    red[kq * 128 + v] = acc; __syncthreads();
    if (tid < 128) Ot[tid] = (red[tid] + red[128 + tid]) + (red[256 + tid] + red[384 + tid]);
    __syncthreads();
    if (wave == 0) { const float x0 = Ot[lane], x1 = Ot[64 + lane]; const float rs = 1.0f / sqrtf(wave_sum(x0 * x0 + x1 * x1) * (1.0f / 128.0f) + EPSF);
        const size_t go = (size_t)row * D + col0 + lane;
        OG[go] = (bf16)f2bf(x0 * rs * gnorm[lane] * bf2f(GH[go])); OG[go + 64] = (bf16)f2bf(x1 * rs * gnorm[64 + lane] * bf2f(GH[go + 64])); }
    __syncthreads();
}
__device__ __forceinline__ int t5_bucket(int d) {
    if (d < 16) return d;
    int lg = 16 + (int)(logf((float)d * (1.0f / 16.0f)) / 2.0794415416798357f * 16.0f);
    return lg > 31 ? 31 : lg;
}
__device__ __forceinline__ void attn_unit(int unit, int jl, const GAS bf16* Q, const GAS bf16* KSH, const GAS bf16* VSH, GAS bf16* ATT, const GAS float* sinks, const GAS float* relb, LAS unsigned char* ldsh, int ht) {
    LAS bf16* Kt = (LAS bf16*)ldsh; LAS bf16* Vt = Kt + 192 * 64; LAS float* bT = (LAS float*)(Vt + 192 * 64);
    const int b = unit >> 9, kv = (unit >> 7) & 3, qb = unit & 127, t0 = qb * 64, rowbase = b * SEQ;
    for (int idx = ht; idx < 192 * 8; idx += 256) { const int s = idx >> 3, ch = idx & 7, sabs = t0 - 128 + s;
        u32x4 kx = (u32x4){0u, 0u, 0u, 0u}, vx = (u32x4){0u, 0u, 0u, 0u};
        if (sabs >= 0) { kx = *(const GAS u32x4*)(KSH + (size_t)(rowbase + sabs) * 256 + kv * 64 + ch * 8); vx = *(const GAS u32x4*)(VSH + (size_t)(rowbase + sabs) * 256 + kv * 64 + ch * 8); }
        *(LAS u32x4*)(Kt + s * 64 + ch * 8) = kx; *(LAS u32x4*)(Vt + s * 64 + ch * 8) = vx; }
    for (int idx = ht; idx < 512; idx += 256) { const int g = idx >> 7, d = idx & 127; bT[idx] = relb[t5_bucket(d) * 16 + kv * 4 + g]; }
    __syncthreads();
    const int qi = ht & 63, g = ht >> 6, t = t0 + qi, head = kv * 4 + g;
    float q[64], o[64];
    { const GAS bf16* qp = Q + (size_t)(rowbase + t) * D + head * 64;
#pragma unroll
      for (int c8 = 0; c8 < 8; ++c8) { const u32x4 w = *(const GAS u32x4*)(qp + c8 * 8);
#pragma unroll
        for (int e = 0; e < 4; ++e) { q[c8 * 8 + 2 * e] = __uint_as_float(w[e] << 16); q[c8 * 8 + 2 * e + 1] = __uint_as_float(w[e] & 0xffff0000u); } } }
#pragma unroll
    for (int d = 0; d < 64; ++d) o[d] = 0.f;
    float m = sinks[jl * 16 + head], lsum = 1.0f;
    for (int s = 0; s < 192; ++s) {
        const int dist = qi + 128 - s, sabs = t0 - 128 + s;
        const bool valid = (dist >= 0) && (dist < 128) && (sabs >= 0);
        if (!__any(valid)) continue;
        float dot = 0.f;
#pragma unroll
        for (int c8 = 0; c8 < 8; ++c8) { const u32x4 w = *(const LAS u32x4*)(Kt + s * 64 + c8 * 8);
#pragma unroll
            for (int e = 0; e < 4; ++e) { dot += q[c8 * 8 + 2 * e] * __uint_as_float(w[e] << 16); dot += q[c8 * 8 + 2 * e + 1] * __uint_as_float(w[e] & 0xffff0000u); } }
        const float scv = dot + bT[g * 128 + (dist & 127)];
        const float mn = valid ? fmaxf(m, scv) : m;
        const float alpha = __expf(m - mn), p = valid ? __expf(scv - mn) : 0.f;
        lsum = lsum * alpha + p; m = mn;
#pragma unroll
        for (int c8 = 0; c8 < 8; ++c8) { const u32x4 w = *(const LAS u32x4*)(Vt + s * 64 + c8 * 8);
#pragma unroll
            for (int e = 0; e < 4; ++e) { o[c8 * 8 + 2 * e] = o[c8 * 8 + 2 * e] * alpha + p * __uint_as_float(w[e] << 16); o[c8 * 8 + 2 * e + 1] = o[c8 * 8 + 2 * e + 1] * alpha + p * __uint_as_float(w[e] & 0xffff0000u); } }
    }
    { const float inv = 1.0f / lsum; GAS bf16* op = ATT + (size_t)(rowbase + t) * D + head * 64;
#pragma unroll
      for (int c8 = 0; c8 < 8; ++c8) { u32x4 w;
#pragma unroll
        for (int e = 0; e < 4; ++e) w[e] = cvt_pk(o[c8 * 8 + 2 * e] * inv, o[c8 * 8 + 2 * e + 1] * inv);
        *(GAS u32x4*)(op + c8 * 8) = w; } }
    __syncthreads();
}
__device__ __forceinline__ void attn_sample_item(int wi, int jl, const GAS bf16* Q, const GAS bf16* KSH, const GAS bf16* VSH, const GAS float* ck, const GAS float* cv, GAS bf16* ATT, const GAS float* sinks, const GAS float* relb,
                                                 LAS float* pbuf, int lane) {
    const int b = wi >> 4, head = wi & 15, kv = head >> 2, row = MP + b;
    float q[64];
    { const GAS bf16* qp = Q + (size_t)row * D + head * 64;
#pragma unroll
      for (int c8 = 0; c8 < 8; ++c8) { const u32x4 w = *(const GAS u32x4*)(qp + c8 * 8);
#pragma unroll
        for (int e = 0; e < 4; ++e) { q[c8 * 8 + 2 * e] = __uint_as_float(w[e] << 16); q[c8 * 8 + 2 * e + 1] = __uint_as_float(w[e] & 0xffff0000u); } } }
    float scv[2];
#pragma unroll
    for (int hh = 0; hh < 2; ++hh) { const int jj = lane + 64 * hh; const GAS float* kp = ck + (size_t)((b * 128 + jj) * 4 + kv) * 64; float dot = 0.f;
#pragma unroll
        for (int c4 = 0; c4 < 16; ++c4) { const f32x4 kx = *(const GAS f32x4*)(kp + 4 * c4); dot += q[4 * c4] * kx[0] + q[4 * c4 + 1] * kx[1] + q[4 * c4 + 2] * kx[2] + q[4 * c4 + 3] * kx[3]; }
        scv[hh] = jj >= 1 ? dot + relb[t5_bucket(128 - jj) * 16 + head] : -1e30f; }
    float scn;
    { const GAS bf16* kp = KSH + (size_t)row * 256 + kv * 64; float dot = 0.f;
#pragma unroll
      for (int c8 = 0; c8 < 8; ++c8) { const u32x4 w = *(const GAS u32x4*)(kp + c8 * 8);
#pragma unroll
        for (int e = 0; e < 4; ++e) { dot += q[c8 * 8 + 2 * e] * __uint_as_float(w[e] << 16); dot += q[c8 * 8 + 2 * e + 1] * __uint_as_float(w[e] & 0xffff0000u); } }
      scn = dot + relb[head]; }
    const float sink = sinks[jl * 16 + head];
    const float m = fmaxf(fmaxf(sink, scn), wave_max(fmaxf(scv[0], scv[1])));
    const float p0 = __expf(scv[0] - m), p1 = __expf(scv[1] - m), pn = __expf(scn - m);
    const float lsum = wave_sum(p0 + p1) + pn + __expf(sink - m);
    pbuf[lane] = p0; pbuf[64 + lane] = p1;
    LDS_WAIT(); asm volatile("" ::: "memory");
    float o = pn * bf2f(VSH[(size_t)row * 256 + kv * 64 + lane]);
#pragma unroll 8
    for (int jj = 1; jj < 128; ++jj) o += pbuf[jj] * cv[(size_t)((b * 128 + jj) * 4 + kv) * 64 + lane];
    ATT[(size_t)row * D + head * 64 + lane] = (bf16)f2bf(o / lsum);
    LDS_WAIT(); asm volatile("" ::: "memory");
}
typedef float f32x16 __attribute__((ext_vector_type(16)));
typedef short v4i16_t __attribute__((ext_vector_type(4)));
constexpr int AT_KROW = 144, AT_VROW = 192, AT_K = 0, AT_V = 192 * AT_KROW, AT_BT = AT_V + 192 * AT_VROW, AT_BK = AT_BT + 4 * 192 * 4, AT_OST = 69632, AT_OROW = 144;
static_assert(AT_BK + 512 <= AT_OST && AT_OST + 8 * 32 * AT_OROW <= RING_BYTES, "attention LDS map");
__device__ __forceinline__ v4i16_t ds_tr16(const LAS unsigned char* p) { return __builtin_amdgcn_ds_read_tr16_b64_v4i16((LAS v4i16_t*)p); }
__device__ __forceinline__ void attn_unit_mfma(int unit, int jl, const GAS bf16* Q, const GAS bf16* KSH, const GAS bf16* VSH, GAS bf16* ATT, const GAS float* sinks, const GAS float* relb,
                                               LAS unsigned char* lds, int tid, int wave, int lane) {
    const int b = unit >> 9, kv = (unit >> 7) & 3, qb = unit & 127, t0 = qb * 64, rowbase = b * SEQ;
    LAS float* BT = (LAS float*)(lds + AT_BT); const LAS int* BK = (const LAS int*)(lds + AT_BK);
#pragma unroll
    for (int i = 0; i < 3; ++i) { const int idx = tid + 512 * i, s = idx >> 3, ch = idx & 7, sabs = t0 - 128 + s;
        u32x4 kx = (u32x4){0u, 0u, 0u, 0u}, vx = (u32x4){0u, 0u, 0u, 0u};
        if (sabs >= 0) { const size_t go = (size_t)(rowbase + sabs) * 256 + kv * 64 + ch * 8; kx = *(const GAS u32x4*)(KSH + go); vx = *(const GAS u32x4*)(VSH + go); }
        *(LAS u32x4*)(lds + AT_K + s * AT_KROW + ch * 16) = kx; *(LAS u32x4*)(lds + AT_V + s * AT_VROW + ch * 16) = vx; }
    for (int idx = tid; idx < 4 * 192; idx += 512) { const int g = idx / 192, i = idx - g * 192, dist = i - 31;
        BT[idx] = (dist >= 0 && dist < 128) ? relb[BK[dist] * 16 + kv * 4 + g] : -1e30f; }
    __syncthreads();
    const int g = wave >> 1, th = wave & 1, head = kv * 4 + g, qi = lane & 31, h = lane >> 5;
    bf16x8 qf[4];
    { const GAS bf16* qp = Q + (size_t)(rowbase + t0 + 32 * th + qi) * D + head * 64 + 8 * h;
#pragma unroll
      for (int s = 0; s < 4; ++s) qf[s] = __builtin_bit_cast(bf16x8, *(const GAS u32x4*)(qp + 16 * s)); }
    f32x16 acc[5];
#pragma unroll
    for (int kg = 0; kg < 5; ++kg) {
#pragma unroll
        for (int rg = 0; rg < 16; ++rg) { const int keyoff = (rg & 3) + 8 * (rg >> 2) + 4 * h; acc[kg][rg] = BT[g * 192 + qi + 128 - 32 * kg - keyoff + 31]; }
        const LAS unsigned char* kp = lds + AT_K + (32 * th + 32 * kg + qi) * AT_KROW + 16 * h;
#pragma unroll
        for (int s = 0; s < 4; ++s) acc[kg] = __builtin_amdgcn_mfma_f32_32x32x16_bf16(*(const LAS bf16x8*)(kp + 32 * s), qf[s], acc[kg], 0, 0, 0);
    }
    if (t0 < 128) {
#pragma unroll
        for (int kg = 0; kg < 5; ++kg)
#pragma unroll
            for (int rg = 0; rg < 16; ++rg) { const int keyoff = (rg & 3) + 8 * (rg >> 2) + 4 * h; if (t0 + 32 * th + 32 * kg + keyoff < 128) acc[kg][rg] = -1e30f; }
    }
    const float sink = sinks[jl * 16 + head];
    float m = sink;
#pragma unroll
    for (int kg = 0; kg < 5; ++kg)
#pragma unroll
        for (int rg = 0; rg < 16; ++rg) m = fmaxf(m, acc[kg][rg]);
    m = fmaxf(m, __shfl_xor(m, 32));
    float sum = 0.f;
#pragma unroll
    for (int kg = 0; kg < 5; ++kg)
#pragma unroll
        for (int rg = 0; rg < 16; ++rg) { const float p = __expf(acc[kg][rg] - m); acc[kg][rg] = p; sum += p; }
    sum += __shfl_xor(sum, 32); sum += __expf(sink - m);
    const float inv = 1.0f / sum;
    f32x16 o[2];
#pragma unroll
    for (int db = 0; db < 2; ++db)
#pragma unroll
        for (int rg = 0; rg < 16; ++rg) o[db][rg] = 0.f;
    const LAS unsigned char* vp = lds + AT_V + (32 * th + 4 * h + ((lane & 15) >> 2)) * AT_VROW + (16 * ((lane >> 4) & 1) + 4 * (lane & 3)) * 2;
#pragma unroll
    for (int kg = 0; kg < 5; ++kg)
#pragma unroll
        for (int s2 = 0; s2 < 2; ++s2) {
            u32x4 pw; pw.x = cvt_pk(acc[kg][8 * s2 + 0], acc[kg][8 * s2 + 1]); pw.y = cvt_pk(acc[kg][8 * s2 + 2], acc[kg][8 * s2 + 3]);
            pw.z = cvt_pk(acc[kg][8 * s2 + 4], acc[kg][8 * s2 + 5]); pw.w = cvt_pk(acc[kg][8 * s2 + 6], acc[kg][8 * s2 + 7]);
            const bf16x8 pb = __builtin_bit_cast(bf16x8, pw);
#pragma unroll
            for (int db = 0; db < 2; ++db) {
                const LAS unsigned char* vq = vp + (32 * kg + 16 * s2) * AT_VROW + 64 * db;
                const v4i16_t lo = ds_tr16(vq), hi = ds_tr16(vq + 8 * AT_VROW);
                const bf16x8 va = (bf16x8){lo[0], lo[1], lo[2], lo[3], hi[0], hi[1], hi[2], hi[3]};
                o[db] = __builtin_amdgcn_mfma_f32_32x32x16_bf16(va, pb, o[db], 0, 0, 0);
            }
        }
    LAS unsigned char* stg = lds + AT_OST + wave * (32 * AT_OROW);
#pragma unroll
    for (int db = 0; db < 2; ++db)
#pragma unroll
        for (int r4 = 0; r4 < 4; ++r4) { u32x2 w; w.x = cvt_pk(o[db][4 * r4] * inv, o[db][4 * r4 + 1] * inv); w.y = cvt_pk(o[db][4 * r4 + 2] * inv, o[db][4 * r4 + 3] * inv);
            *(LAS u32x2*)(stg + qi * AT_OROW + (32 * db + 8 * r4 + 4 * h) * 2) = w; }
    LDS_WAIT(); asm volatile("" ::: "memory");
#pragma unroll
    for (int i = 0; i < 4; ++i) { const int row = i * 8 + (lane >> 3), ch = lane & 7; const u32x4 v = *(const LAS u32x4*)(stg + row * AT_OROW + ch * 16);
        *(GAS u32x4*)(ATT + (size_t)(rowbase + t0 + 32 * th + row) * D + head * 64 + ch * 8) = v; }
    __syncthreads();
}
__global__ void __launch_bounds__(NWAVES * 64, 2) yoco_fwd(Args args) {
    extern __shared__ __attribute__((aligned(16))) unsigned char lds_raw[];
    LAS unsigned char* lds = (LAS unsigned char*)lds_raw;
    volatile LAS unsigned* MISC = (volatile LAS unsigned*)(lds + MISC_OFF);
    const int tid0 = threadIdx.x, G0 = gridDim.x, bx0 = blockIdx.x;
    const int tid = tid0;
    gu32* ctl = (gu32*)(args.ws + WS_CTL);
    for (int u = tid; u < (LDS_BYTES - LDSCTL_OFF) / 4; u += NWAVES * 64) ((LAS unsigned*)(lds + LDSCTL_OFF))[u] = 0u;
    __syncthreads();
    XcdBarrier bar = xcd_barrier_post((unsigned*)(ctl + CW_BAR), MISC + 8);
#define GRID_BAR() xcd_barrier(bar)

    volatile LAS unsigned long long* PT = (volatile LAS unsigned long long*)(lds + PTAB_OFF);
    if (tid < 25) PT[tid] = (unsigned long long)args.in[tid];
    if (tid == 25) PT[25] = (unsigned long long)args.out;
    if (tid == 26) PT[26] = (unsigned long long)args.ws;
    __syncthreads();
#define PF(i) ((const GAS float*)ldptr(PT, (i)))
#define POUT ((GAS float*)ldptr(PT, 25))
#define PWS ((GAS unsigned char*)ldptr(PT, 26))

    enum { T_P0, T_NORMX, T_INPROJ, T_SCANA, T_SCANB, T_SCANC, T_QPROJ, T_ATTN, T_RES, T_NORM, T_FFN1, T_KV };
    constexpr int NPH = 2 + 2 * 9 + 1 + 2 * 7;
#pragma unroll 1
    for (int ph = 0; ph < NPH; ++ph) {
        int tid = tid0, G = G0, bx = bx0; asm volatile("" : "+v"(tid)); asm volatile("" : "+s"(G), "+s"(bx));
        const int lane = tid & 63, wave = __builtin_amdgcn_readfirstlane(tid >> 6);
        const int vcu = (G % 8 == 0) ? (bx % 8) * (G / 8) + bx / 8 : bx, gw = vcu * NWAVES + wave, NGW = G * NWAVES;
        int type, l = 0, half = 0;
#ifdef PROBE_A
        if (bx0 == 0 && tid0 == 0) ((volatile LAS unsigned long long*)(lds + LDSCTL_OFF + 2048))[ph] = __builtin_amdgcn_s_memrealtime();
#endif
        if (ph == 0) type = T_P0;
        else if (ph == 1) type = T_NORMX;
        else { const int p = ph - 2;
            if (p < 18) { l = p >= 9 ? 1 : 0; const int st = p - 9 * l;
                type = st == 0 ? T_INPROJ : st == 1 ? T_SCANA : st == 2 ? T_SCANB : st == 3 ? T_SCANC : st == 4 ? T_RES : st == 5 ? T_NORM : st == 6 ? T_FFN1 : st == 7 ? T_RES : T_NORM; half = st >= 6 ? 1 : 0; }
            else if (p == 18) { type = T_KV; l = 1; }
            else { const int p2 = p - 19; l = 2 + (p2 >= 7 ? 1 : 0); const int st = p2 - 7 * (l - 2);
                type = st == 0 ? T_QPROJ : st == 1 ? T_ATTN : st == 2 ? T_RES : st == 3 ? T_NORM : st == 4 ? T_FFN1 : st == 5 ? T_RES : T_NORM; half = st >= 4 ? 1 : 0; } }
        if (type == T_P0) {
            p0_ada(PT, lds, vcu, G, tid, wave, lane);
            p0_transposes(PT, lds, gw, NGW, wave, lane);
        } else if (type == T_NORMX) {
            GAS unsigned char* ws = PWS; const GAS float* ADA = (const GAS float*)(ws + WS_ADA);
            norm_pass<1>(gw, NGW, lane, nullptr, PF(I_XP), PF(I_XS), (GAS float*)(ws + WS_H), PF(I_NORMW), ADA + 0 * D, ADA + 1 * D, ADAW, (GAS bf16*)(ws + WS_XN), nullptr, nullptr, nullptr, 0, nullptr, nullptr);
        } else if (type == T_INPROJ) {
            GAS unsigned char* ws = PWS; const GAS float* lb = PF(I_LB);
            pg8::Gemm g{(const GAS bf16*)(ws + WS_XN), (const GAS bf16*)(ws + WS_WIN) + (size_t)l * WIN_SZ, MP, 4096, D}; pg8::StaticOrder S; S.init(MP, 4096, G, bx);
            EpiInProj E{ws, lb, lb + D, l};
            pg8::gemm_phase<EpiInProj, pg8::StaticOrder, true, true>(lds + RING_OFF, g, S, E, tid);
            { SEpiInProj SE{ws, lb, lb + D, l}; skinny_gemm<1>(g.A + (size_t)MP * D, g.Bt, 4096, D, SE, lds, vcu, G, wave, lane); }
        } else if (type == T_SCANA) {
            GAS unsigned char* ws = PWS; const GAS float* gn = PF(I_GNORM) + l * 128;
            for (int u = vcu; u < NUNIT; u += G) scan_unit<false>(u, (const GAS bf16*)(ws + WS_QH), (const GAS float*)(ws + WS_LF), (const GAS bf16*)(ws + WS_VH), (const GAS bf16*)(ws + WS_GH), (GAS float*)(ws + WS_SCAN), (GAS float*)(ws + WS_DLOG), (GAS bf16*)(ws + WS_OG), gn, lds, tid, wave, lane);
            const GAS float* st0 = PF(I_STATE); GAS float* out = POUT;
            for (int su = vcu; su < MS * 8; su += G) scan_sample_unit(su, l, (const GAS bf16*)(ws + WS_QH), (const GAS float*)(ws + WS_LF), (const GAS bf16*)(ws + WS_VH), (const GAS bf16*)(ws + WS_GH), st0, out, (GAS bf16*)(ws + WS_OG), gn, lds, tid, wave, lane);
        } else if (type == T_SCANB) {
            GAS unsigned char* ws = PWS; scan_combine(l, (GAS float*)(ws + WS_SCAN), (const GAS float*)(ws + WS_DLOG), POUT, vcu * NWAVES * 64 + tid, G * NWAVES * 64);
        } else if (type == T_SCANC) {
            GAS unsigned char* ws = PWS; const GAS float* gn = PF(I_GNORM) + l * 128;
            for (int u = vcu; u < NUNIT; u += G) scan_unit<true>(u, (const GAS bf16*)(ws + WS_QH), (const GAS float*)(ws + WS_LF), (const GAS bf16*)(ws + WS_VH), (const GAS bf16*)(ws + WS_GH), (GAS float*)(ws + WS_SCAN), (GAS float*)(ws + WS_DLOG), (GAS bf16*)(ws + WS_OG), gn, lds, tid, wave, lane);
        } else if (type == T_QPROJ) {
            GAS unsigned char* ws = PWS;
            pg8::Gemm g{(const GAS bf16*)(ws + WS_XN), (const GAS bf16*)(ws + WS_WQ) + (size_t)(l - 2) * WOA_SZ, MP, D, D}; pg8::StaticOrder S; S.init(MP, D, G, bx);
            EpiQ E{(GAS bf16*)(ws + WS_QH)};
            pg8::gemm_phase<EpiQ, pg8::StaticOrder, true, true>(lds + RING_OFF, g, S, E, tid);
            { SEpiQ SE{(GAS bf16*)(ws + WS_QH)}; skinny_gemm<4>(g.A + (size_t)MP * D, g.Bt, D, D, SE, lds, vcu, G, wave, lane); }
        } else if (type == T_ATTN) {
            GAS unsigned char* ws = PWS; const GAS float* sinks = PF(I_SINKS); const GAS float* relb = PF(I_RELB); const int jl = l - 2;
            if (tid < 128) ((LAS int*)(lds + AT_BK))[tid] = t5_bucket(tid);
            __syncthreads();
            for (int it = vcu; it < 1024; it += G) attn_unit_mfma(it, jl, (const GAS bf16*)(ws + WS_QH), (const GAS bf16*)(ws + WS_KSH), (const GAS bf16*)(ws + WS_VSH), (GAS bf16*)(ws + WS_OG), sinks, relb, lds, tid, wave, lane);
            LAS float* pbuf = (LAS float*)(lds + 110592 + wave * 512);
            const GAS float* ck = PF(I_CK); const GAS float* cv = PF(I_CV);
            for (int wi = gw; wi < MS * 16; wi += NGW) attn_sample_item(wi, jl, (const GAS bf16*)(ws + WS_QH), (const GAS bf16*)(ws + WS_KSH), (const GAS bf16*)(ws + WS_VSH), ck, cv, (GAS bf16*)(ws + WS_OG), sinks, relb, pbuf, lane);
        } else if (type == T_FFN1) {
            GAS unsigned char* ws = PWS;
            pg8::Gemm g{(const GAS bf16*)(ws + WS_XN), (const GAS bf16*)(ws + WS_WF1) + (size_t)l * WF1_SZ, MP, NFF2, D}; pg8::StaticOrder S; S.init(MP, NFF2, G, bx);
            EpiSwiGLU E{(GAS bf16*)(ws + WS_ACT)};
            pg8::gemm_phase<EpiSwiGLU, pg8::StaticOrder, true, true>(lds + RING_OFF, g, S, E, tid);
            { SEpiSwiGLU SE{(GAS bf16*)(ws + WS_ACT)}; skinny_gemm<1>(g.A + (size_t)MP * D, g.Bt, NFF2, D, SE, lds, vcu, G, wave, lane); }
        } else if (type == T_RES) {
            GAS unsigned char* ws = PWS;
            const GAS bf16* Ap = half == 0 ? (const GAS bf16*)(ws + WS_OG) : (const GAS bf16*)(ws + WS_ACT);
            const GAS bf16* Bp = half == 0 ? (l < 2 ? (const GAS bf16*)(ws + WS_WOA) + (size_t)l * WOA_SZ : (const GAS bf16*)(ws + WS_WOB) + (size_t)(l - 2) * WOA_SZ) : (const GAS bf16*)(ws + WS_WF2) + (size_t)l * WF2_SZ;
            pg8::Gemm g{Ap, Bp, MP, D, half == 0 ? D : DFF}; pg8::StaticOrder S; S.init(MP, D, G, bx);
            EpiRes E{(GAS float*)(ws + WS_H), (const GAS float*)(ws + WS_ADA) + (size_t)l * NCOND * ADAW + (half == 0 ? 2 : 5) * D};
            pg8::gemm_phase<EpiRes, pg8::StaticOrder, true, true>(lds + RING_OFF, g, S, E, tid);
            { SEpiRes SE{E.H, E.gate}; skinny_gemm<4>(Ap + (size_t)MP * g.K, Bp, D, g.K, SE, lds, vcu, G, wave, lane); }
        } else if (type == T_NORM) {
            GAS unsigned char* ws = PWS; const GAS float* NW = PF(I_NORMW); const GAS float* ADAl = (const GAS float*)(ws + WS_ADA) + (size_t)l * NCOND * ADAW; const GAS float* ADAn = ADAl + NCOND * ADAW;
            const GAS float* Hc = (const GAS float*)(ws + WS_H); GAS bf16* XN = (GAS bf16*)(ws + WS_XN);
            if (half == 0) norm_pass<0>(gw, NGW, lane, Hc, nullptr, nullptr, nullptr, NW + (l * 2 + 1) * D, ADAl + 3 * D, ADAl + 4 * D, ADAW, XN, nullptr, nullptr, nullptr, 0, nullptr, nullptr);
            else if (l == 3) norm_pass<3>(gw, NGW, lane, Hc, nullptr, nullptr, nullptr, PF(I_FNORM), nullptr, nullptr, 0, nullptr, nullptr, nullptr, nullptr, 0, nullptr, POUT);
            else if (l == 1) norm_pass<2>(gw, NGW, lane, Hc, nullptr, nullptr, nullptr, NW + ((l + 1) * 2) * D, ADAn + 0 * D, ADAn + 1 * D, ADAW, XN,
                                          PF(I_KVNORM), (const GAS float*)(ws + WS_ADAKV), (const GAS float*)(ws + WS_ADAKV) + D, 2048, (GAS bf16*)(ws + WS_XNKV), nullptr);
            else norm_pass<0>(gw, NGW, lane, Hc, nullptr, nullptr, nullptr, NW + ((l + 1) * 2) * D, ADAn + 0 * D, ADAn + 1 * D, ADAW, XN, nullptr, nullptr, nullptr, 0, nullptr, nullptr);
        } else {
            { GAS unsigned char* ws = PWS; GAS float* out = POUT;
              pg8::Gemm g{(const GAS bf16*)(ws + WS_XNKV), (const GAS bf16*)(ws + WS_WKV), MP, 512, D}; pg8::StaticOrder S; S.init(MP, 512, G, bx);
              EpiKV E{(GAS bf16*)(ws + WS_KSH), (GAS bf16*)(ws + WS_VSH), out};
              pg8::gemm_phase<EpiKV, pg8::StaticOrder, true, true>(lds + RING_OFF, g, S, E, tid);
              { SEpiKV SE{E.KSH, E.VSH, out}; skinny_gemm<4>(g.A + (size_t)MP * D, g.Bt, 512, D, SE, lds, vcu, G, wave, lane); } }
            { GAS float* out = POUT; const GAS float* ck = PF(I_CK); const GAS float* cv = PF(I_CV);
              const int gt = vcu * NWAVES * 64 + tid, NGT = G * NWAVES * 64;
              for (int e = gt; e < MS * 127 * 64; e += NGT) { const int b = e / (127 * 64), r = e % (127 * 64);
                  *(GAS f32x4*)(out + OCK_S + (size_t)b * 32768 + 4 * r) = *(const GAS f32x4*)(ck + (size_t)b * 32768 + 256 + 4 * r);
                  *(GAS f32x4*)(out + OCV_S + (size_t)b * 32768 + 4 * r) = *(const GAS f32x4*)(cv + (size_t)b * 32768 + 256 + 4 * r); } }
        }
#ifdef PROBE_A
        if (bx0 == 0 && tid0 == 0) { ((volatile LAS unsigned*)(lds + LDSCTL_OFF + 2048 + 512))[ph] = (unsigned)(type == T_RES ? 100 + half : type == T_NORM ? 200 + half : type);
                                     ((volatile LAS unsigned long long*)(lds + LDSCTL_OFF + 2048 + 1024))[ph] = __builtin_amdgcn_s_memrealtime(); }
#endif
        GRID_BAR();
    }
#ifdef PROBE_A
    if (bx0 == 0) {
        volatile LAS unsigned long long* TS = (volatile LAS unsigned long long*)(lds + LDSCTL_OFF + 2048); volatile LAS unsigned* TY = (volatile LAS unsigned*)(lds + LDSCTL_OFF + 2048 + 512);
        volatile LAS unsigned long long* TE = (volatile LAS unsigned long long*)(lds + LDSCTL_OFF + 2048 + 1024);
        volatile LAS float* RES = (volatile LAS float*)(lds + LDSCTL_OFF + 2048 + 1536);
        if (tid0 == 0) { const unsigned long long tend = __builtin_amdgcn_s_memrealtime(); unsigned long long ta = 0, tb = 0;
            for (int ph = 0; ph < NPH; ++ph) { const unsigned long long full = (ph + 1 < NPH ? TS[ph + 1] : tend) - TS[ph], work = TE[ph] - TS[ph]; const int ty = (int)TY[ph];
                const unsigned long long va = PROBE_A >= 1000 ? ((ty == PROBE_A - 1000) ? work : 0ull) : ((ty == PROBE_A) ? full : 0ull);
                const unsigned long long vb = PROBE_B >= 1000 ? ((ty == PROBE_B - 1000) ? work : 0ull) : ((ty == PROBE_B) ? full : 0ull);
                ta += va; tb += vb; }
            RES[0] = sqrtf((float)ta * 0.01f * 1e-5f); RES[1] = 1.0f + (float)tb * 0.01f * 0.01f; }
        __syncthreads();
        GAS float* out = POUT; const float dl = RES[0], da = RES[1];
        for (int i = tid0; i < 65536; i += NWAVES * 64) out[OCK_P + i] *= (1.0f + dl);
        if (tid0 == 0) out[0] += da;
    }
#endif
}

extern "C" void kernel_launch(void* const* d_in, const int* in_sizes, int n_in, void* d_out, int out_size, void* d_ws, size_t ws_size, hipStream_t stream) {
    static int grid = 0;
    if (grid == 0) {
        if (n_in != 25 || (size_t)out_size != OUT_TOTAL || ws_size < WS_END) { fprintf(stderr, "kernel_launch: unexpected problem: n_in %d out %d ws %zu (need >= %zu)\n", n_in, out_size, ws_size, (size_t)WS_END); grid = -1; return; }
        int dev = 0, cus = 0, per_cu = 0;
        if (hipGetDevice(&dev) != hipSuccess || hipDeviceGetAttribute(&cus, hipDeviceAttributeMultiprocessorCount, dev) != hipSuccess) { fprintf(stderr, "kernel_launch: device query failed\n"); grid = -1; return; }
        if (hipFuncSetAttribute((const void*)yoco_fwd, hipFuncAttributeMaxDynamicSharedMemorySize, LDS_BYTES) != hipSuccess) { fprintf(stderr, "kernel_launch: hipFuncSetAttribute failed\n"); grid = -1; return; }
        if (hipOccupancyMaxActiveBlocksPerMultiprocessor(&per_cu, (const void*)yoco_fwd, NWAVES * 64, LDS_BYTES) != hipSuccess || per_cu < 1)
            fprintf(stderr, "kernel_launch: note: occupancy query reports %d workgroups per CU\n", per_cu);
        (void)hipGetLastError();
        grid = cus;
    }
    if (grid < 0) return;
    if (hipMemsetAsync((char*)d_ws + WS_CTL, 0, CTL_ZERO_BYTES, stream) != hipSuccess) { fprintf(stderr, "kernel_launch: hipMemsetAsync failed\n"); return; }
    Args a{};
    for (int i = 0; i < 25; ++i) a.in[i] = (const GAS float*)d_in[i];
    a.out = (GAS float*)d_out; a.ws = (GAS unsigned char*)d_ws;
    hipLaunchKernelGGL(yoco_fwd, dim3(grid), dim3(NWAVES * 64), LDS_BYTES, stream, a);
    const hipError_t le = hipPeekAtLastError();
    if (le != hipSuccess) fprintf(stderr, "kernel_launch: launch failed: %s\n", hipGetErrorName(le));
}
```

```cpp
#include <hip/hip_runtime.h>
#include <cstdio>
#include <cstdint>
#define GAS __attribute__((address_space(1)))
#define LAS __attribute__((address_space(3)))
namespace pg8 {
#define PG8_LAS __attribute__((address_space(3)))
typedef unsigned short bf16_t;
typedef short bf16x8 __attribute__((ext_vector_type(8)));
typedef float f32x4 __attribute__((ext_vector_type(4)));
typedef unsigned u32x4 __attribute__((ext_vector_type(4)));
constexpr int BM = 256, BK = 64, HALF = 128, HTB = HALF * BK * 2  , STAGE_BYTES = 8 * HTB, NXCD = 8, WGM = 8;

__host__ __device__ __forceinline__ int lds_byte(int r, int c) { const int st = (r >> 4) * 2 + (c >> 5), rr = r & 15, cc = c & 31, ob = rr * 64 + cc * 2; return st * 1024 + (ob ^ (((ob >> 9) & 1) << 5)); }
__host__ __device__ __forceinline__ void stage_rc(int b, int& R, int& C) { const int st = b / 1024, sb = b % 1024, swz = sb ^ (((sb >> 9) & 1) << 5); R = (st >> 1) * 16 + swz / 64; C = (st & 1) * 32 + (swz % 64) / 2; }
__host__ __device__ __forceinline__ int perm32(int rho) { const int n = rho >> 4, i = rho & 15; return 8 * (i >> 2) + 4 * n + (i & 3); }

struct Unit { int pm, pn; };
struct Gemm { const GAS bf16_t* A; const GAS bf16_t* Bt; int M, N, K; };

struct StaticOrder {
    int nM, nN, nwg, G, c;
    __host__ __device__ void init(int M, int N, int G_, int c_) { nM = M / BM; nN = N / BM; nwg = nM * nN; G = G_; c = c_; }
    __host__ __device__ bool next(int i, Unit& u) const {
        const long L = (long)i * G + c; if (L >= nwg) return false;
        int wgid = (int)L; { const int q = nwg / NXCD, r = nwg % NXCD, xcd = wgid % NXCD, off = wgid / NXCD; wgid = (xcd < r ? xcd * (q + 1) : r * (q + 1) + (xcd - r) * q) + off; }
        const int nig = WGM * nN, gid = wgid / nig, fm = gid * WGM, gsz = (nM - fm) < WGM ? (nM - fm) : WGM;
        u.pm = fm + ((wgid % nig) % gsz); u.pn = (wgid % nig) / gsz; return true;
    }
    __device__ __forceinline__ void a_ready(const Unit&) const {}
    __device__ __forceinline__ void done(const Unit&) const {}
};

template <class Epi, class Sched, bool ALIGN_EPI = false, bool SP2 = false>
__device__ __forceinline__ void gemm_phase(PG8_LAS unsigned char* lds, const Gemm g, const Sched& S, const Epi& E, const int tid_in) {
    const int tid = tid_in, wid = __builtin_amdgcn_readfirstlane(tid >> 6), lane = tid & 63, wr = wid >> 2, wc = wid & 3, fr = lane & 15, fq = lane >> 4;
    const int K = g.K, nt = K / BK;
    unsigned voffA[2], voffB[2];
#pragma unroll
    for (int i = 0; i < 2; ++i) { int R, C; stage_rc(tid * 16 + i * 8192, R, C); const int Rb = Epi::PERM ? ((R & ~31) + perm32(R & 31)) : R;
        voffA[i] = (unsigned)(R * K + C) * 2u; voffB[i] = (unsigned)(Rb * K + C) * 2u; }
    const size_t kstep = (size_t)(BK * 2);
    const size_t hstep = (size_t)HALF * K * 2;
    const size_t tstep = 2 * hstep;
    const unsigned ldsw = (unsigned)wid * 1024u;
    const int aoff = lds_byte(wr * 64 + fr, fq * 8), boff = lds_byte(wc * 32 + fr, fq * 8);
#define PG8_SA(b, h) (((b) * 2 + (h)) * HTB)
#define PG8_SB(b, h) ((4 + (b) * 2 + (h)) * HTB)
#define PG8_STAGE(bufoff, gbase, voff) do { _Pragma("unroll") for (int _i = 0; _i < 2; ++_i) \
        __builtin_amdgcn_global_load_lds((const GAS unsigned*)((const GAS char*)(gbase) + (voff)[_i]), (PG8_LAS unsigned*)(lds + (bufoff) + ldsw + _i * 8192), 16, 0, 0); } while (0)
#define PG8_LDA(dst, b, h) do { _Pragma("unroll") for (int m = 0; m < 4; ++m) _Pragma("unroll") for (int k = 0; k < 2; ++k) dst[m][k] = *(const PG8_LAS bf16x8*)(lds + PG8_SA(b, h) + aoff + m * 2048 + k * 1024); } while (0)
#define PG8_LDB(dst, b, h) do { _Pragma("unroll") for (int n = 0; n < 2; ++n) _Pragma("unroll") for (int k = 0; k < 2; ++k) dst[n][k] = *(const PG8_LAS bf16x8*)(lds + PG8_SB(b, h) + boff + n * 2048 + k * 1024); } while (0)
#define PG8_MMA(ai, bj, At, Bt) do { __builtin_amdgcn_s_setprio(1); _Pragma("unroll") for (int m = 0; m < 4; ++m) _Pragma("unroll") for (int n = 0; n < 2; ++n) _Pragma("unroll") for (int k = 0; k < 2; ++k) \
        acc[ai][bj][m][n] = __builtin_amdgcn_mfma_f32_16x16x32_bf16(Bt[n][k], At[m][k], acc[ai][bj][m][n], 0, 0, 0); __builtin_amdgcn_s_setprio(0); } while (0)
#define PG8_WAIT_V(n) asm volatile("s_waitcnt vmcnt(" #n ")" ::: "memory")
#define PG8_WAIT_L(n) asm volatile("s_waitcnt lgkmcnt(" #n ")" ::: "memory")
#define PG8_BAR __builtin_amdgcn_s_barrier()
#define PG8_SCHED __builtin_amdgcn_sched_barrier(0)
    Unit cur, nxt; int ui = 0;
    if (!S.next(0, cur)) return;
    f32x4 acc[2][2][4][2];
#pragma unroll
    for (int a = 0; a < 2; ++a)
#pragma unroll
        for (int b = 0; b < 2; ++b)
#pragma unroll
            for (int m = 0; m < 4; ++m)
#pragma unroll
                for (int n = 0; n < 2; ++n) acc[a][b][m][n] = (f32x4){0.f, 0.f, 0.f, 0.f};
    bf16x8 At[4][2], B0[2][2], B1[2][2];
    const GAS char* cA = (const GAS char*)g.A + (size_t)cur.pm * tstep; const GAS char* cB = (const GAS char*)g.Bt + (size_t)cur.pn * tstep;
    S.a_ready(cur);
    if constexpr (SP2) {
        PG8_STAGE(PG8_SB(0, 0), cB, voffB); PG8_STAGE(PG8_SB(0, 1), cB + hstep, voffB); PG8_STAGE(PG8_SA(0, 0), cA, voffA); PG8_STAGE(PG8_SA(0, 1), cA + hstep, voffA);
        if (wr == 1) PG8_BAR;
        PG8_WAIT_V(2); PG8_BAR;
        PG8_STAGE(PG8_SB(1, 0), cB + kstep, voffB); PG8_STAGE(PG8_SA(1, 0), cA + kstep, voffA); PG8_STAGE(PG8_SB(1, 1), cB + hstep + kstep, voffB);
        PG8_WAIT_V(6); PG8_BAR;
    } else {
        PG8_STAGE(PG8_SB(0, 0), cB, voffB); PG8_STAGE(PG8_SA(0, 0), cA, voffA); PG8_STAGE(PG8_SB(0, 1), cB + hstep, voffB); PG8_STAGE(PG8_SA(0, 1), cA + hstep, voffA);
        if (wr == 1) PG8_BAR;
        PG8_WAIT_V(4); PG8_BAR;
        PG8_STAGE(PG8_SB(1, 0), cB + kstep, voffB); PG8_STAGE(PG8_SA(1, 0), cA + kstep, voffA); PG8_STAGE(PG8_SB(1, 1), cB + hstep + kstep, voffB);
        PG8_WAIT_V(6); PG8_BAR;
    }
    for (;;) {
        const bool has_next = S.next(ui + 1, nxt);
        const GAS char* nA = has_next ? (const GAS char*)g.A + (size_t)nxt.pm * tstep : cA; const GAS char* nB = has_next ? (const GAS char*)g.Bt + (size_t)nxt.pn * tstep : cB;
        for (int t = 0; t < nt; t += 2) {
            const bool last = (t == nt - 2);
            const GAS char* a1 = cA + (size_t)(t + 1) * kstep;
            const GAS char* a2 = last ? nA : cA + (size_t)(t + 2) * kstep; const GAS char* b2 = last ? nB : cB + (size_t)(t + 2) * kstep;
            const GAS char* a3 = a2 + kstep; const GAS char* b3 = b2 + kstep;
            if (last && has_next) S.a_ready(nxt);
            if constexpr (SP2) {
            PG8_LDB(B0, 0, 0); PG8_LDB(B1, 0, 1); PG8_SCHED; PG8_LDA(At, 0, 0); PG8_STAGE(PG8_SA(1, 1), a1 + hstep, voffA);
            PG8_WAIT_V(8); PG8_WAIT_L(0); PG8_BAR; PG8_MMA(0, 0, At, B0); PG8_MMA(0, 1, At, B1); PG8_BAR; PG8_SCHED;
            PG8_LDA(At, 0, 1); PG8_STAGE(PG8_SB(0, 0), b2, voffB); PG8_STAGE(PG8_SB(0, 1), b2 + hstep, voffB); PG8_STAGE(PG8_SA(0, 0), a2, voffA);
            PG8_WAIT_V(8); PG8_WAIT_L(0); PG8_BAR; PG8_MMA(1, 0, At, B0); PG8_MMA(1, 1, At, B1); PG8_BAR; PG8_SCHED;
            PG8_LDB(B0, 1, 0); PG8_LDB(B1, 1, 1); PG8_SCHED; PG8_LDA(At, 1, 0); PG8_STAGE(PG8_SA(0, 1), a2 + hstep, voffA);
            PG8_WAIT_V(8); PG8_WAIT_L(0); PG8_BAR; PG8_MMA(0, 0, At, B0); PG8_MMA(0, 1, At, B1); PG8_BAR; PG8_SCHED;
            PG8_LDA(At, 1, 1); PG8_STAGE(PG8_SB(1, 0), b3, voffB); PG8_STAGE(PG8_SB(1, 1), b3 + hstep, voffB); PG8_STAGE(PG8_SA(1, 0), a3, voffA);
            PG8_WAIT_V(8); PG8_WAIT_L(0); PG8_BAR; PG8_MMA(1, 0, At, B0); PG8_MMA(1, 1, At, B1); PG8_BAR; PG8_SCHED;
            } else {
            PG8_LDB(B0, 0, 0); PG8_SCHED; PG8_LDA(At, 0, 0); PG8_STAGE(PG8_SA(1, 1), a1 + hstep, voffA);
            PG8_WAIT_L(8); PG8_BAR; PG8_WAIT_L(0); PG8_MMA(0, 0, At, B0); PG8_BAR; PG8_SCHED;
            PG8_LDB(B1, 0, 1); PG8_STAGE(PG8_SB(0, 0), b2, voffB);
            PG8_BAR; PG8_WAIT_L(0); PG8_MMA(0, 1, At, B1); PG8_BAR;
            PG8_LDA(At, 0, 1); PG8_STAGE(PG8_SA(0, 0), a2, voffA);
            PG8_BAR; PG8_WAIT_L(0); PG8_MMA(1, 0, At, B0); PG8_BAR; PG8_SCHED;
            PG8_STAGE(PG8_SB(0, 1), b2 + hstep, voffB);
            PG8_WAIT_V(6); PG8_BAR; PG8_MMA(1, 1, At, B1); PG8_BAR;
            PG8_LDB(B0, 1, 0); PG8_SCHED; PG8_LDA(At, 1, 0); PG8_STAGE(PG8_SA(0, 1), a2 + hstep, voffA);
            PG8_WAIT_L(8); PG8_BAR; PG8_WAIT_L(0); PG8_MMA(0, 0, At, B0); PG8_BAR; PG8_SCHED;
            PG8_LDB(B1, 1, 1); PG8_STAGE(PG8_SB(1, 0), b3, voffB);
            PG8_BAR; PG8_WAIT_L(0); PG8_MMA(0, 1, At, B1); PG8_BAR;
            PG8_LDA(At, 1, 1); PG8_STAGE(PG8_SA(1, 0), a3, voffA);
            PG8_BAR; PG8_WAIT_L(0); PG8_MMA(1, 0, At, B0); PG8_BAR; PG8_SCHED;
            PG8_STAGE(PG8_SB(1, 1), b3 + hstep, voffB);
            PG8_WAIT_V(6); PG8_BAR; PG8_MMA(1, 1, At, B1); PG8_BAR;
            }
        }
        if constexpr (ALIGN_EPI) { if (wr == 0) PG8_BAR; }
        if constexpr (!Epi::AFTER_DRAIN) { E(acc, cur, wr, wc, fr, fq); S.done(cur); }
        if (!has_next) break;
#pragma unroll
        for (int a = 0; a < 2; ++a)
#pragma unroll
            for (int b = 0; b < 2; ++b)
#pragma unroll
                for (int m = 0; m < 4; ++m)
#pragma unroll
                    for (int n = 0; n < 2; ++n) acc[a][b][m][n] = (f32x4){0.f, 0.f, 0.f, 0.f};
        cur = nxt; cA = nA; cB = nB; ++ui;
        if constexpr (ALIGN_EPI) { if (wr == 1) PG8_BAR; }
    }
    PG8_WAIT_V(0);
    if constexpr (!ALIGN_EPI) { if (wr == 0) PG8_BAR; }
    PG8_BAR;
    if constexpr (Epi::AFTER_DRAIN) { E.fused(acc, cur, wr, wc, fr, fq, lds, wid, lane); S.done(cur); }
#undef PG8_SA
#undef PG8_SB
#undef PG8_STAGE
#undef PG8_LDA
#undef PG8_LDB
#undef PG8_MMA
#undef PG8_WAIT_V
#undef PG8_WAIT_L
#undef PG8_BAR
#undef PG8_SCHED
}
}


typedef unsigned short bf16;
typedef unsigned v4u __attribute__((ext_vector_type(4)));
typedef float f32x4 __attribute__((ext_vector_type(4)));
typedef short bf16x8 __attribute__((ext_vector_type(8)));
typedef GAS unsigned gu32;
typedef GAS unsigned long long gu64;
#define RLX_AGENT __ATOMIC_RELAXED, __HIP_MEMORY_SCOPE_AGENT
#define LDS_WAIT() asm volatile("s_waitcnt lgkmcnt(0)" ::: "memory")
#define VM_WAIT() asm volatile("s_waitcnt vmcnt(0)" ::: "memory")
__device__ __forceinline__ unsigned long long rt() { return __builtin_amdgcn_s_memrealtime(); }
__device__ __forceinline__ unsigned f2bf(float f) { unsigned u = __builtin_bit_cast(unsigned, f); return (u + 0x7fffu + ((u >> 16) & 1u)) >> 16; }
__device__ __forceinline__ unsigned pk2(float lo, float hi) { return f2bf(lo) | (f2bf(hi) << 16); }

#define XB_TMO      128
#define XB_XCNT(j)  (256  + 64 * (j))
#define XB_XSUB(j)  (1280 + 64 * (j))
#define XB_XGEN(j)  (2304 + 64 * (j))
#define XB_TOP      3328
#define XB_TOPGEN   3392
#define XCD_BAR_WORDS 3456
#define XB_SPIN_CAP (1u << 18)

__device__ __forceinline__ unsigned xb_ld(unsigned* p)              { return __hip_atomic_load(p, __ATOMIC_RELAXED, __HIP_MEMORY_SCOPE_AGENT); }
__device__ __forceinline__ unsigned xb_add(unsigned* p, unsigned v) { return __hip_atomic_fetch_add(p, v, __ATOMIC_RELAXED, __HIP_MEMORY_SCOPE_AGENT); }
__device__ __forceinline__ unsigned xb_xcc_id() { return (unsigned)__builtin_amdgcn_s_getreg((3 << 11) | 20) & 0xFu; }
#define XB_SPIN(cond, bar) do { unsigned _sp = 0; while (cond) { __builtin_amdgcn_s_sleep(1); \
    if ((++_sp & 255u) == 0u) { if (xb_ld(&(bar)[XB_TMO])) break; if (_sp > XB_SPIN_CAP) { atomicAdd(&(bar)[XB_TMO], 1u); break; } } } } while (0)

struct XcdBarrier {
    unsigned* bar; unsigned x;
    volatile LAS unsigned* st;
};

__device__ __forceinline__ XcdBarrier xcd_barrier_post(unsigned* bar, volatile LAS unsigned* st) {
    XcdBarrier b; b.bar = bar; b.x = xb_xcc_id(); b.st = st;
    if (threadIdx.x == 0) (void)xb_add(&bar[XB_XCNT(b.x)], 1u);
    return b;
}
__device__ __forceinline__ void xcd_barrier_complete(unsigned* bar, unsigned x, unsigned& nloc, unsigned& nx) {
    const unsigned G = gridDim.x * gridDim.y * gridDim.z;
    unsigned sum, cnt, mine, sp = 0u;
    for (;;) {
        sum = 0u; cnt = 0u; mine = 0u;
#pragma unroll
        for (unsigned j = 0; j < 16; ++j) { const unsigned c = xb_ld(&bar[XB_XCNT(j)]); sum += c; cnt += (c > 0u) ? 1u : 0u; mine = (j == x) ? c : mine; }
        if (sum == G) break;
        __builtin_amdgcn_s_sleep(1);
        if ((++sp & 255u) == 0u) { if (xb_ld(&bar[XB_TMO])) break; if (sp > XB_SPIN_CAP) { atomicAdd(&bar[XB_TMO], 1u); break; } }
    }
    nloc = mine > 0u ? mine : 1u; nx = cnt > 0u ? cnt : 1u;
}

__device__ __forceinline__ void xcd_barrier(const XcdBarrier& b) {
    asm volatile("s_waitcnt vmcnt(0)" ::: "memory");
    __syncthreads();
    if (threadIdx.x == 0) {
        unsigned* bar = b.bar;
        __builtin_amdgcn_s_waitcnt(0);
        unsigned nloc = b.st[0], nx = b.st[1];
        if (nloc == 0u) { xcd_barrier_complete(bar, b.x, nloc, nx); b.st[0] = nloc; b.st[1] = nx; }
        const unsigned old = xb_add(&bar[XB_XSUB(b.x)], 1u);
        const unsigned gen = old / nloc;
        if (old + 1u == (gen + 1u) * nloc) {
            __builtin_amdgcn_fence(__ATOMIC_RELEASE, "agent");
            asm volatile("s_waitcnt vmcnt(0)" ::: "memory");
            const unsigned og = xb_add(&bar[XB_TOP], 1u);
            const unsigned tg = og / nx;
            if (og + 1u == (tg + 1u) * nx) xb_add(&bar[XB_TOPGEN], 1u);
            else XB_SPIN(xb_ld(&bar[XB_TOPGEN]) == tg, bar);
            __builtin_amdgcn_fence(__ATOMIC_ACQUIRE, "agent");
            xb_add(&bar[XB_XGEN(b.x)], 1u);
            asm volatile("s_waitcnt vmcnt(0)" ::: "memory");
        } else {
            XB_SPIN(xb_ld(&bar[XB_XGEN(b.x)]) == gen, bar);
            __builtin_amdgcn_fence(__ATOMIC_ACQUIRE, "agent");
            asm volatile("s_waitcnt vmcnt(0)" ::: "memory");
        }
    }
    __syncthreads();
}
typedef pg8::u32x4 u32x4;
typedef unsigned u32x2 __attribute__((ext_vector_type(2)));
constexpr int D = 1024, SEQ = 8192, MP = 16384, MS = 128, MT = MP + MS, MPAD = 16640;
constexpr int DFF = 2816, NFF2 = 2 * DFF, NCOND = 130, ADAW = 6 * D;
constexpr float EPSF = 1e-6f;
constexpr size_t OY_P = 0, OY_S = 16777216, OST_P = 16908288, OST_S = 17432576, OCK_P = 50987008, OCV_P = 51052544, OCK_S = 51118080, OCV_S = 55312384, OUT_TOTAL = 59506688;

typedef float f32x2_t __attribute__((ext_vector_type(2))); typedef __bf16 bf16x2_t __attribute__((ext_vector_type(2)));
__device__ __forceinline__ unsigned cvt_pk(float lo, float hi) { const f32x2_t v = {lo, hi}; const bf16x2_t b = __builtin_convertvector(v, bf16x2_t); return __builtin_bit_cast(unsigned, b); }
__device__ __forceinline__ float bf2f(unsigned short u) { return __uint_as_float((unsigned)u << 16); }
__device__ __forceinline__ float silu_f(float x) { return x / (1.0f + __expf(-x)); }
__device__ __forceinline__ float sigmoid_f(float x) { return 1.0f / (1.0f + __expf(-x)); }
__device__ __forceinline__ int cond_of(int row) { return row < MP ? 128 + (row >> 13) : ((row - MP) < MS ? (row - MP) : MS - 1); }

constexpr size_t MiB = 1u << 20;
constexpr size_t WS_CTL = 0, CTL_ZERO_BYTES = 1 * MiB;
constexpr size_t WS_WIN = 1 * MiB, WS_WOA = 17 * MiB, WS_WKV = 21 * MiB, WS_WQ = 22 * MiB, WS_WOB = 26 * MiB, WS_WF1 = 30 * MiB, WS_WF2 = 74 * MiB;
constexpr size_t WS_ADA = 96 * MiB, WS_ADAKV = 109 * MiB;
constexpr size_t WS_SCAN = 111 * MiB, WS_DLOG = 127 * MiB;
constexpr size_t WS_H = 128 * MiB;
constexpr size_t WS_XN = 193 * MiB, WS_OG = 226 * MiB;
constexpr size_t WS_KSH = 259 * MiB, WS_VSH = 268 * MiB;
constexpr size_t WS_QH = 277 * MiB, WS_LF = 310 * MiB, WS_VH = 375 * MiB, WS_GH = 408 * MiB;
constexpr size_t WS_ACT = 277 * MiB;
constexpr size_t WS_XNKV = 408 * MiB;
constexpr size_t WS_END = 441 * MiB;
static_assert(WS_ACT + (size_t)MPAD * DFF * 2 <= WS_VH && WS_H + (size_t)MPAD * D * 4 <= WS_XN && WS_ADA + (size_t)4 * NCOND * ADAW * 4 <= WS_ADAKV, "d_ws map");
constexpr int CW_BAR = 4096;
constexpr int WIN_SZ = 4096 * 1024, WOA_SZ = 1024 * 1024, WF1_SZ = NFF2 * 1024, WF2_SZ = 1024 * DFF;
constexpr int RING_OFF = 0, RING_BYTES = 131072, LDSCTL_OFF = RING_BYTES, MISC_OFF = LDSCTL_OFF + 320, LDS_BYTES = 147456;
constexpr int NWAVES = 8;
#define EPI_LOOP_BEGIN \
    _Pragma("unroll") for (int ai = 0; ai < 2; ++ai) _Pragma("unroll") for (int m = 0; m < 4; ++m) { const int row = u.pm * 256 + ai * 128 + wr * 64 + m * 16 + fr; \
    _Pragma("unroll") for (int bj = 0; bj < 2; ++bj) { const int ct = bj * 128 + wc * 32 + 8 * fq; const f32x4 v0 = acc[ai][bj][m][0], v1 = acc[ai][bj][m][1];
#define EPI_LOOP_END } }

struct EpiInProj {
    static constexpr bool PERM = true, AFTER_DRAIN = false;
    GAS unsigned char* ws; const GAS float* lb0; const GAS float* lb1; int layer;
    __device__ __forceinline__ void operator()(const f32x4 (&acc)[2][2][4][2], const pg8::Unit& u, int wr, int wc, int fr, int fq) const {
        const int kind = u.pn >> 2, cb = (u.pn & 3) * 256;
        EPI_LOOP_BEGIN
            const int c = cb + ct; const size_t off = (size_t)row * D + c;
            if (kind == 1) {
                f32x4 o0, o1;
#pragma unroll
                for (int j = 0; j < 4; ++j) {
                    float lba = 0.f, lbb = 0.f;
                    if (layer == 1) { lba = sigmoid_f(lb1[c + j] - lb0[c + j]); lbb = sigmoid_f(lb1[c + 4 + j] - lb0[c + 4 + j]); }
                    const float fa = lba + (1.0f - lba) * sigmoid_f(v0[j]), fb = lbb + (1.0f - lbb) * sigmoid_f(v1[j]);
                    o0[j] = logf(fmaxf(fa, 1e-30f)); o1[j] = logf(fmaxf(fb, 1e-30f));
                }
                GAS float* LF = (GAS float*)(ws + WS_LF); *(GAS f32x4*)(LF + off) = o0; *(GAS f32x4*)(LF + off + 4) = o1;
            } else {
                f32x4 a = v0, b = v1;
                if (kind != 2) {
#pragma unroll
                    for (int j = 0; j < 4; ++j) { a[j] = silu_f(a[j]); b[j] = silu_f(b[j]); }
                }
                u32x4 w; w.x = cvt_pk(a[0], a[1]); w.y = cvt_pk(a[2], a[3]); w.z = cvt_pk(b[0], b[1]); w.w = cvt_pk(b[2], b[3]);
                const size_t ob = kind == 0 ? WS_QH : (kind == 2 ? WS_VH : WS_GH); GAS bf16* dst = (GAS bf16*)(ws + ob);
                *(GAS u32x4*)(dst + off) = w;
            }
        EPI_LOOP_END
    }
};
struct EpiRes {
    static constexpr bool PERM = true, AFTER_DRAIN = false;
    GAS float* H; const GAS float* gate;
    __device__ __forceinline__ void operator()(const f32x4 (&acc)[2][2][4][2], const pg8::Unit& u, int wr, int wc, int fr, int fq) const {
        const int c0 = u.pn * 256 + wc * 32 + 8 * fq;
        const bool uni = u.pm < MP / 256;
        f32x4 gu[2][2];
        { const GAS float* gp = gate + (size_t)cond_of(u.pm * 256) * ADAW + c0;
#pragma unroll
          for (int bj = 0; bj < 2; ++bj) { gu[bj][0] = *(const GAS f32x4*)(gp + bj * 128); gu[bj][1] = *(const GAS f32x4*)(gp + bj * 128 + 4); } }
#pragma unroll
        for (int am = 0; am < 4; ++am) { const int ai = am >> 1, m0 = (am & 1) * 2;
            f32x4 hv[4][2][2];
#pragma unroll
            for (int m = m0; m < m0 + 2; ++m) { const int row = u.pm * 256 + ai * 128 + wr * 64 + m * 16 + fr; const GAS float* hp = H + (size_t)row * D + c0;
#pragma unroll
                for (int bj = 0; bj < 2; ++bj) { hv[m][bj][0] = *(const GAS f32x4*)(hp + bj * 128); hv[m][bj][1] = *(const GAS f32x4*)(hp + bj * 128 + 4); } }
#pragma unroll
            for (int m = m0; m < m0 + 2; ++m) { const int row = u.pm * 256 + ai * 128 + wr * 64 + m * 16 + fr; GAS float* hp = H + (size_t)row * D + c0;
                f32x4 g[2][2];
                if (uni) {
#pragma unroll
                    for (int bj = 0; bj < 2; ++bj) { g[bj][0] = gu[bj][0]; g[bj][1] = gu[bj][1]; }
                } else { const GAS float* gp = gate + (size_t)cond_of(row) * ADAW + c0;
#pragma unroll
                    for (int bj = 0; bj < 2; ++bj) { g[bj][0] = *(const GAS f32x4*)(gp + bj * 128); g[bj][1] = *(const GAS f32x4*)(gp + bj * 128 + 4); } }
#pragma unroll
                for (int bj = 0; bj < 2; ++bj) { *(GAS f32x4*)(hp + bj * 128) = hv[m][bj][0] + g[bj][0] * acc[ai][bj][m][0]; *(GAS f32x4*)(hp + bj * 128 + 4) = hv[m][bj][1] + g[bj][1] * acc[ai][bj][m][1]; } }
        }
    }
};
struct EpiSwiGLU {
    static constexpr bool PERM = true, AFTER_DRAIN = false;
    GAS bf16* ACT;
    __device__ __forceinline__ void operator()(const f32x4 (&acc)[2][2][4][2], const pg8::Unit& u, int wr, int wc, int fr, int fq) const {
        EPI_LOOP_BEGIN
            const int oc = (u.pn * 256 + ct) >> 1;
            u32x2 w; w.x = cvt_pk(silu_f(v0[0]) * v1[0], silu_f(v0[1]) * v1[1]); w.y = cvt_pk(silu_f(v0[2]) * v1[2], silu_f(v0[3]) * v1[3]);
            *(GAS u32x2*)(ACT + (size_t)row * DFF + oc) = w;
        EPI_LOOP_END
    }
};
struct EpiKV {
    static constexpr bool PERM = true, AFTER_DRAIN = false;
    GAS bf16* KSH; GAS bf16* VSH; GAS float* out;
    __device__ __forceinline__ void operator()(const f32x4 (&acc)[2][2][4][2], const pg8::Unit& u, int wr, int wc, int fr, int fq) const {
        GAS bf16* dst = u.pn == 0 ? KSH : VSH;
        EPI_LOOP_BEGIN
            const int c = ct;
            u32x4 w; w.x = cvt_pk(v0[0], v0[1]); w.y = cvt_pk(v0[2], v0[3]); w.z = cvt_pk(v1[0], v1[1]); w.w = cvt_pk(v1[2], v1[3]);
            *(GAS u32x4*)(dst + (size_t)row * 256 + c) = w;
            GAS float* o = nullptr;
            if (row < MP) { const int t = row & (SEQ - 1), b = row >> 13; if (t >= SEQ - 128) o = out + (u.pn == 0 ? OCK_P : OCV_P) + ((size_t)(b * 128 + (t - (SEQ - 128))) * 256 + c); }
            else if (row < MT) { o = out + (u.pn == 0 ? OCK_S : OCV_S) + ((size_t)((row - MP) * 128 + 127) * 256 + c); }
            if (o) { *(GAS f32x4*)o = v0; *(GAS f32x4*)(o + 4) = v1; }
        EPI_LOOP_END
    }
};
struct EpiQ {
    static constexpr bool PERM = true, AFTER_DRAIN = false;
    GAS bf16* Q;
    __device__ __forceinline__ void operator()(const f32x4 (&acc)[2][2][4][2], const pg8::Unit& u, int wr, int wc, int fr, int fq) const {
        EPI_LOOP_BEGIN
            const int c = u.pn * 256 + ct;
            u32x4 w; w.x = cvt_pk(v0[0] * 0.125f, v0[1] * 0.125f); w.y = cvt_pk(v0[2] * 0.125f, v0[3] * 0.125f); w.z = cvt_pk(v1[0] * 0.125f, v1[1] * 0.125f); w.w = cvt_pk(v1[2] * 0.125f, v1[3] * 0.125f);
            *(GAS u32x4*)(Q + (size_t)row * D + c) = w;
        EPI_LOOP_END
    }
};
template <int KS, class SEpi>
__device__ __forceinline__ void skinny_gemm(const GAS bf16* A, const GAS bf16* Bt, int N, int K, const SEpi& E, LAS unsigned char* lds, int vcu, int G, int wave, int lane) {
    const int r = lane & 15, g = lane >> 4, nitems = (N / 16) * (KS == 4 ? 4 : 1), ksteps = K / (32 * KS);
    LAS f32x4* red = (LAS f32x4*)lds;
    for (int it = vcu; it < nitems; it += G) {
        const int nt = KS == 4 ? (it >> 2) : it, mt = KS == 4 ? 2 * (it & 3) + (wave >> 2) : wave, kq = KS == 4 ? (wave & 3) : 0;
        const GAS bf16* ap = A + (size_t)(mt * 16 + r) * K + (size_t)kq * (K / KS) + 8 * g;
        const GAS bf16* bp = Bt + (size_t)(nt * 16 + r) * K + (size_t)kq * (K / KS) + 8 * g;
        f32x4 acc = (f32x4){0.f, 0.f, 0.f, 0.f};
#pragma unroll 8
        for (int s = 0; s < ksteps; ++s) {
            const bf16x8 af = __builtin_bit_cast(bf16x8, *(const GAS u32x4*)(ap + 32 * s)), bf = __builtin_bit_cast(bf16x8, *(const GAS u32x4*)(bp + 32 * s));
            acc = __builtin_amdgcn_mfma_f32_16x16x32_bf16(bf, af, acc, 0, 0, 0);
        }
        if (KS == 4) {
            red[wave * 64 + lane] = acc; __syncthreads();
            if ((wave & 3) == 0) acc = (red[wave * 64 + lane] + red[(wave + 1) * 64 + lane]) + (red[(wave + 2) * 64 + lane] + red[(wave + 3) * 64 + lane]);
        }
        const bool owner = KS == 4 ? (wave & 3) == 0 : true;
        E(MP + mt * 16 + r, nt * 16 + 4 * g, acc, owner);
        if (KS == 4) __syncthreads();
    }
}
struct SEpiInProj {
    GAS unsigned char* ws; const GAS float* lb0; const GAS float* lb1; int layer;
    __device__ __forceinline__ void operator()(int row, int col, f32x4 v, bool owner) const {
        if (!owner) return;
        const int kind = col >> 10, c = col & 1023; const size_t off = (size_t)row * D + c;
        if (kind == 1) { f32x4 o;
#pragma unroll
            for (int j = 0; j < 4; ++j) { float lb = 0.f; if (layer == 1) lb = sigmoid_f(lb1[c + j] - lb0[c + j]);
                o[j] = logf(fmaxf(lb + (1.0f - lb) * sigmoid_f(v[j]), 1e-30f)); }
            *(GAS f32x4*)((GAS float*)(ws + WS_LF) + off) = o;
        } else {
            if (kind != 2) {
#pragma unroll
                for (int j = 0; j < 4; ++j) v[j] = silu_f(v[j]);
            }
            u32x2 w; w.x = cvt_pk(v[0], v[1]); w.y = cvt_pk(v[2], v[3]);
            const size_t ob = kind == 0 ? WS_QH : (kind == 2 ? WS_VH : WS_GH);
            *(GAS u32x2*)((GAS bf16*)(ws + ob) + off) = w;
        }
    }
};
struct SEpiRes {
    GAS float* H; const GAS float* gate;
    __device__ __forceinline__ void operator()(int row, int col, f32x4 v, bool owner) const {
        if (!owner) return;
        const f32x4 g = *(const GAS f32x4*)(gate + (size_t)cond_of(row) * ADAW + col);
        GAS f32x4* hp = (GAS f32x4*)(H + (size_t)row * D + col); *hp = *hp + g * v;
    }
};
struct SEpiSwiGLU {
    GAS bf16* ACT;
    __device__ __forceinline__ void operator()(int row, int col, f32x4 v, bool owner) const {
        f32x4 up;
#pragma unroll
        for (int j = 0; j < 4; ++j) up[j] = __shfl_xor(v[j], 16);
        if (!owner || ((col >> 2) & 1)) return;
        u32x2 w; w.x = cvt_pk(silu_f(v[0]) * up[0], silu_f(v[1]) * up[1]); w.y = cvt_pk(silu_f(v[2]) * up[2], silu_f(v[3]) * up[3]);
        *(GAS u32x2*)(ACT + (size_t)row * DFF + (col >> 1)) = w;
    }
};
struct SEpiKV {
    GAS bf16* KSH; GAS bf16* VSH; GAS float* out;
    __device__ __forceinline__ void operator()(int row, int col, f32x4 v, bool owner) const {
        if (!owner) return;
        const int isv = col >> 8, c = col & 255;
        u32x2 w; w.x = cvt_pk(v[0], v[1]); w.y = cvt_pk(v[2], v[3]);
        *(GAS u32x2*)((isv ? VSH : KSH) + (size_t)row * 256 + c) = w;
        *(GAS f32x4*)(out + (isv ? OCV_S : OCK_S) + ((size_t)((row - MP) * 128 + 127) * 256 + c)) = v;
    }
};
struct SEpiQ {
    GAS bf16* Q;
    __device__ __forceinline__ void operator()(int row, int col, f32x4 v, bool owner) const {
        if (!owner) return;
        u32x2 w; w.x = cvt_pk(v[0] * 0.125f, v[1] * 0.125f); w.y = cvt_pk(v[2] * 0.125f, v[3] * 0.125f);
        *(GAS u32x2*)(Q + (size_t)row * D + col) = w;
    }
};
struct Args { const GAS float* in[25]; GAS float* out; GAS unsigned char* ws; };
constexpr int PTAB_OFF = LDSCTL_OFF + 1024;
__device__ __forceinline__ unsigned long long ldptr(volatile LAS unsigned long long* tab, int i) {
    const unsigned long long v = tab[i];
    const unsigned lo = __builtin_amdgcn_readfirstlane((unsigned)v), hi = __builtin_amdgcn_readfirstlane((unsigned)(v >> 32));
    return ((unsigned long long)hi << 32) | lo;
}
#define PTF(i) ((const GAS float*)ldptr(PT, (i)))
enum { I_XP = 0, I_XS, I_STATE, I_CK, I_CV, I_CP, I_CS, I_WIN, I_WOA, I_GNORM, I_LB, I_WKV, I_WADAKV, I_BADAKV, I_KVNORM, I_WQ, I_WOB, I_SINKS, I_RELB, I_NORMW, I_WADA, I_BADA, I_WF1, I_WF2, I_FNORM };

__device__ __forceinline__ float wave_sum(float v) {
#pragma unroll
    for (int o = 1; o < 64; o <<= 1) v += __shfl_xor(v, o);
    return v;
}
__device__ __forceinline__ float wave_max(float v) {
#pragma unroll
    for (int o = 1; o < 64; o <<= 1) v = fmaxf(v, __shfl_xor(v, o));
    return v;
}
__device__ __forceinline__ void transpose_item(const GAS float* W, int K, int N, GAS bf16* WT, int mode, LAS float* scr, int item, int lane) {
    const int nblk = N / 32, kb = item / nblk, nb = item % nblk, k0 = 64 * kb, n0 = 32 * nb;
#pragma unroll 8
    for (int i = 0; i < 32; ++i) { const int kk = 2 * i + (lane >> 5); scr[kk * 33 + (lane & 31)] = W[(size_t)(k0 + kk) * N + n0 + (lane & 31)]; }
    LDS_WAIT(); asm volatile("" ::: "memory");
    const int c = lane & 7;
#pragma unroll
    for (int j = 0; j < 4; ++j) { const int n = (lane >> 3) + 8 * j; const LAS float* s = scr + (8 * c) * 33 + n;
        v4u o; o.x = pk2(s[0 * 33], s[1 * 33]); o.y = pk2(s[2 * 33], s[3 * 33]); o.z = pk2(s[4 * 33], s[5 * 33]); o.w = pk2(s[6 * 33], s[7 * 33]);
        const int gn = n0 + n; int drow = gn;
        if (mode == 1) { const int up = gn >= DFF ? 1 : 0; const int jn = up ? gn - DFF : gn; drow = 8 * (jn >> 2) + (jn & 3) + 4 * up; }
        *(GAS v4u*)(WT + (size_t)drow * K + k0 + 8 * c) = o; }
    LDS_WAIT(); asm volatile("" ::: "memory");
}
__device__ __forceinline__ void p0_transposes(volatile LAS unsigned long long* PT, LAS unsigned char* lds, int gw, int NGW, int wave, int lane) {
    LAS float* scr = (LAS float*)(lds + RING_OFF + 16384 + wave * 12288);
    GAS unsigned char* ws = (GAS unsigned char*)ldptr(PT, 26);
    constexpr int I_IN = 16 * 128, I_SQ = 16 * 32, I_KV = 16 * 16, I_F1 = 16 * (NFF2 / 32), I_F2 = (DFF / 64) * 32;
    constexpr int TOTAL = 2 * I_IN + 2 * I_SQ + I_KV + 2 * I_SQ + 2 * I_SQ + 4 * I_F1 + 4 * I_F2;
    for (int it = gw; it < TOTAL; it += NGW) {
        int r = it; const GAS float* W; GAS bf16* WT; int K = D, N = D, mode = 0, item;
        if (r < 4 * I_F1) { const int l = r / I_F1; W = PTF(I_WF1) + (size_t)l * D * NFF2; N = NFF2; WT = (GAS bf16*)(ws + WS_WF1) + (size_t)l * WF1_SZ; mode = 1; item = r % I_F1; }
        else if ((r -= 4 * I_F1) < 4 * I_F2) { const int l = r / I_F2; W = PTF(I_WF2) + (size_t)l * DFF * D; K = DFF; WT = (GAS bf16*)(ws + WS_WF2) + (size_t)l * WF2_SZ; item = r % I_F2; }
        else if ((r -= 4 * I_F2) < 2 * I_IN) { const int l = r / I_IN; W = PTF(I_WIN) + (size_t)l * D * 4096; N = 4096; WT = (GAS bf16*)(ws + WS_WIN) + (size_t)l * WIN_SZ; item = r % I_IN; }
        else if ((r -= 2 * I_IN) < 2 * I_SQ) { const int l = r / I_SQ; W = PTF(I_WOA) + (size_t)l * D * D; WT = (GAS bf16*)(ws + WS_WOA) + (size_t)l * WOA_SZ; item = r % I_SQ; }
        else if ((r -= 2 * I_SQ) < 2 * I_SQ) { const int l = r / I_SQ; W = PTF(I_WQ) + (size_t)l * D * D; WT = (GAS bf16*)(ws + WS_WQ) + (size_t)l * WOA_SZ; item = r % I_SQ; }
        else if ((r -= 2 * I_SQ) < 2 * I_SQ) { const int l = r / I_SQ; W = PTF(I_WOB) + (size_t)l * D * D; WT = (GAS bf16*)(ws + WS_WOB) + (size_t)l * WOA_SZ; item = r % I_SQ; }
        else { r -= 2 * I_SQ; W = PTF(I_WKV); N = 512; WT = (GAS bf16*)(ws + WS_WKV); item = r; }
        transpose_item(W, K, N, WT, mode, scr, item, lane);
    }
}
__device__ __forceinline__ bf16x8 silu8_bf16(const GAS float* p) {
    const f32x4 x0 = *(const GAS f32x4*)p, x1 = *(const GAS f32x4*)(p + 4);
    u32x4 w; w.x = cvt_pk(silu_f(x0[0]), silu_f(x0[1])); w.y = cvt_pk(silu_f(x0[2]), silu_f(x0[3])); w.z = cvt_pk(silu_f(x1[0]), silu_f(x1[1])); w.w = cvt_pk(silu_f(x1[2]), silu_f(x1[3]));
    return __builtin_bit_cast(bf16x8, w);
}
__device__ __forceinline__ void ada_item(const GAS float* W, int ldw, int n0, const GAS float* bias, const GAS float* c_s, const GAS float* c_p, GAS float* outp, int ldo, LAS unsigned char* lds, int tid, int wave, int lane) {
    LAS bf16* Wt = (LAS bf16*)lds;
    const int kk = tid >> 4, n4 = tid & 15, r = lane & 15, g = lane >> 4;
    f32x4 acc[4], acc9[4];
#pragma unroll
    for (int q = 0; q < 4; ++q) { acc[q] = (f32x4){0.f, 0.f, 0.f, 0.f}; acc9[q] = (f32x4){0.f, 0.f, 0.f, 0.f}; }
    f32x4 wreg = *(const GAS f32x4*)(W + (size_t)kk * ldw + n0 + 4 * n4);
    for (int ks = 0; ks < 32; ++ks) {
        const int buf = ks & 1;
#pragma unroll
        for (int j = 0; j < 4; ++j) Wt[(buf * 64 + 4 * n4 + j) * 40 + kk] = (bf16)f2bf(wreg[j]);
        __syncthreads();
        if (ks + 1 < 32) wreg = *(const GAS f32x4*)(W + (size_t)((ks + 1) * 32 + kk) * ldw + n0 + 4 * n4);
        const bf16x8 af = silu8_bf16(c_s + (size_t)(16 * wave + r) * D + 32 * ks + 8 * g);
        bf16x8 bfr[4];
#pragma unroll
        for (int q = 0; q < 4; ++q) bfr[q] = *(const LAS bf16x8*)(Wt + (buf * 64 + 16 * q + r) * 40 + 8 * g);
#pragma unroll
        for (int q = 0; q < 4; ++q) acc[q] = __builtin_amdgcn_mfma_f32_16x16x32_bf16(af, bfr[q], acc[q], 0, 0, 0);
        if (wave == 0) {
            bf16x8 a9 = (bf16x8){0, 0, 0, 0, 0, 0, 0, 0};
            if (r < 2) a9 = silu8_bf16(c_p + (size_t)r * D + 32 * ks + 8 * g);
#pragma unroll
            for (int q = 0; q < 4; ++q) acc9[q] = __builtin_amdgcn_mfma_f32_16x16x32_bf16(a9, bfr[q], acc9[q], 0, 0, 0);
        }
    }
#pragma unroll
    for (int q = 0; q < 4; ++q) { const int n = n0 + 16 * q + r; const float bv = bias[n];
#pragma unroll
        for (int rg = 0; rg < 4; ++rg) { outp[(size_t)(16 * wave + 4 * g + rg) * ldo + n] = acc[q][rg] + bv;
            if (wave == 0 && g == 0 && rg < 2) outp[(size_t)(128 + rg) * ldo + n] = acc9[q][rg] + bv; } }
    __syncthreads();
}
__device__ __forceinline__ void p0_ada(volatile LAS unsigned long long* PT, LAS unsigned char* lds, int vcu, int G, int tid, int wave, int lane) {
    GAS unsigned char* ws = (GAS unsigned char*)ldptr(PT, 26);
    constexpr int PER_L = ADAW / 64, NIT = 4 * PER_L + 2048 / 64;
    for (int it = vcu; it < NIT; it += G) {
        if (it < 4 * PER_L) { const int l = it / PER_L, nb = it % PER_L;
            ada_item(PTF(I_WADA) + (size_t)l * D * ADAW, ADAW, 64 * nb, PTF(I_BADA) + (size_t)l * ADAW, PTF(I_CS), PTF(I_CP), (GAS float*)(ws + WS_ADA) + (size_t)l * NCOND * ADAW, ADAW, lds, tid, wave, lane); }
        else { const int nb = it - 4 * PER_L;
            ada_item(PTF(I_WADAKV), 2048, 64 * nb, PTF(I_BADAKV), PTF(I_CS), PTF(I_CP), (GAS float*)(ws + WS_ADAKV), 2048, lds, tid, wave, lane); }
    }
}
template <int MODE>
__device__ __forceinline__ void norm_pass(int gw, int NGW, int lane, const GAS float* H, const GAS float* xp, const GAS float* xs, GAS float* Hc,
                                          const GAS float* nw, const GAS float* sh, const GAS float* sc, int ldc, GAS bf16* XN,
                                          const GAS float* nw2, const GAS float* sh2, const GAS float* sc2, int ldc2, GAS bf16* XN2, GAS float* out) {
    for (int row = gw; row < MT; row += NGW) {
        const GAS float* src = MODE == 1 ? (row < MP ? xp + (size_t)row * D : xs + (size_t)(row - MP) * D) : H + (size_t)row * D;
        f32x4 v[4]; float ss = 0.f;
#pragma unroll
        for (int j = 0; j < 4; ++j) { v[j] = *(const GAS f32x4*)(src + 4 * lane + 256 * j); ss += (v[j][0] * v[j][0] + v[j][1] * v[j][1]) + (v[j][2] * v[j][2] + v[j][3] * v[j][3]); }
        const float rstd = 1.0f / sqrtf(wave_sum(ss) * (1.0f / D) + EPSF);
        const int ci = cond_of(row);
#pragma unroll
        for (int j = 0; j < 4; ++j) {
            const int c = 4 * lane + 256 * j;
            if (MODE == 1) *(GAS f32x4*)(Hc + (size_t)row * D + c) = v[j];
            if (MODE == 3) {
                const f32x4 w = *(const GAS f32x4*)(nw + c);
                GAS float* o = row < MP ? out + OY_P + (size_t)row * D + c : out + OY_S + (size_t)(row - MP) * D + c;
                *(GAS f32x4*)o = v[j] * rstd * w;
            } else {
                const f32x4 w = *(const GAS f32x4*)(nw + c), s1 = *(const GAS f32x4*)(sc + (size_t)ci * ldc + c), b1 = *(const GAS f32x4*)(sh + (size_t)ci * ldc + c);
                const f32x4 y = (v[j] * rstd * w) * (1.0f + s1) + b1;
                u32x2 p; p.x = cvt_pk(y[0], y[1]); p.y = cvt_pk(y[2], y[3]);
                *(GAS u32x2*)(XN + (size_t)row * D + c) = p;
                if (MODE == 2) {
                    const f32x4 w2 = *(const GAS f32x4*)(nw2 + c), s2 = *(const GAS f32x4*)(sc2 + (size_t)ci * ldc2 + c), b2 = *(const GAS f32x4*)(sh2 + (size_t)ci * ldc2 + c);
                    const f32x4 y2 = (v[j] * rstd * w2) * (1.0f + s2) + b2;
                    u32x2 p2; p2.x = cvt_pk(y2[0], y2[1]); p2.y = cvt_pk(y2[2], y2[3]);
                    *(GAS u32x2*)(XN2 + (size_t)row * D + c) = p2;
                }
            }
        }
    }
}
constexpr int SCT = 512, NSC = SEQ / SCT, TT = 32, NUNIT = 2 * 8 * NSC;
template <bool PASS_C>
__device__ __forceinline__ void scan_unit(int unit, const GAS bf16* QH, const GAS float* LF, const GAS bf16* VH, const GAS bf16* GH, GAS float* U, GAS float* DLOG, GAS bf16* OG, const GAS float* gnorm,
                                          LAS unsigned char* lds, int tid, int wave, int lane) {
    LAS float* Ft = (LAS float*)lds; LAS float* Qt = Ft + TT * 128; LAS float* Vt = Qt + TT * 128; LAS float* Ot = Vt + TT * 128;
    const int b = unit >> 7, h = (unit >> 4) & 7, sc = unit & 15, row0 = b * SEQ + sc * SCT, col0 = h * 128;
    const int vloc = lane & 15, kp = lane >> 4, v = 16 * wave + vloc;
    float s[32];
#pragma unroll
    for (int i = 0; i < 32; ++i) s[i] = PASS_C ? U[(size_t)unit * 16384 + (32 * kp + i) * 128 + v] : 0.f;
    const int sk = tid & 127, sq = tid >> 7;
    float slf = 0.f;
    for (int tile = 0; tile < SCT / TT; ++tile) {
        const int rowt = row0 + tile * TT;
#pragma unroll
        for (int j = 0; j < TT / 4; ++j) { const int t = sq + 4 * j; const size_t go = (size_t)(rowt + t) * D + col0 + sk;
            const float lf = LF[go]; Ft[t * 128 + sk] = __expf(lf); slf += lf;
            Vt[t * 128 + sk] = bf2f(VH[go]); if (PASS_C) Qt[t * 128 + sk] = bf2f(QH[go]); }
        __syncthreads();
        for (int t = 0; t < TT; ++t) {
            const float vv = Vt[t * 128 + v]; float acc = 0.f;
#pragma unroll
            for (int i4 = 0; i4 < 8; ++i4) {
                const f32x4 f = *(const LAS f32x4*)(Ft + t * 128 + 32 * kp + 4 * i4);
                f32x4 q = (f32x4){0.f, 0.f, 0.f, 0.f}; if (PASS_C) q = *(const LAS f32x4*)(Qt + t * 128 + 32 * kp + 4 * i4);
#pragma unroll
                for (int e = 0; e < 4; ++e) { const float sn = f[e] * (s[4 * i4 + e] - vv) + vv; s[4 * i4 + e] = sn; if (PASS_C) acc += q[e] * sn; }
            }
            if (PASS_C) { acc += __shfl_xor(acc, 16); acc += __shfl_xor(acc, 32); if (kp == 0) Ot[t * 128 + v] = acc; }
        }
        if (PASS_C) {
            __syncthreads();
#pragma unroll
            for (int r = 0; r < 4; ++r) { const int t = 4 * wave + r; const float x0 = Ot[t * 128 + lane], x1 = Ot[t * 128 + 64 + lane];
                const float rs = 1.0f / sqrtf(wave_sum(x0 * x0 + x1 * x1) * (1.0f / 128.0f) + EPSF);
                const size_t go = (size_t)(rowt + t) * D + col0 + lane;
                OG[go] = (bf16)f2bf(x0 * rs * gnorm[lane] * bf2f(GH[go])); OG[go + 64] = (bf16)f2bf(x1 * rs * gnorm[64 + lane] * bf2f(GH[go + 64])); }
        }
        __syncthreads();
    }
    if (!PASS_C) {
#pragma unroll
        for (int i = 0; i < 32; ++i) U[(size_t)unit * 16384 + (32 * kp + i) * 128 + v] = s[i];
        Ft[sq * 128 + sk] = slf; __syncthreads();
        if (tid < 128) DLOG[unit * 128 + tid] = (Ft[tid] + Ft[128 + tid]) + (Ft[256 + tid] + Ft[384 + tid]);
        __syncthreads();
    }
}
__device__ __forceinline__ void scan_combine(int layer, GAS float* U, const GAS float* DLOG, GAS float* out, int gt, int NGT) {
    for (int e = gt; e < 16 * 16384; e += NGT) {
        const int bh = e >> 14, idx = e & 16383, k = idx >> 7;
        float uv[NSC], dv[NSC];
#pragma unroll
        for (int sc = 0; sc < NSC; ++sc) { uv[sc] = U[(size_t)(bh * NSC + sc) * 16384 + idx]; dv[sc] = DLOG[(bh * NSC + sc) * 128 + k]; }
        float S = 0.f;
#pragma unroll
        for (int sc = 0; sc < NSC; ++sc) { U[(size_t)(bh * NSC + sc) * 16384 + idx] = S; S = __expf(dv[sc]) * S + uv[sc]; }
        const int b = bh >> 3, h = bh & 7;
        out[OST_P + (size_t)((b * 2 + layer) * 8 + h) * 16384 + idx] = S;
    }
}
__device__ __forceinline__ void scan_sample_unit(int su, int layer, const GAS bf16* QH, const GAS float* LF, const GAS bf16* VH, const GAS bf16* GH, const GAS float* S0g, GAS float* out, GAS bf16* OG, const GAS float* gnorm,
                                                 LAS unsigned char* lds, int tid, int wave, int lane) {
    LAS float* red = (LAS float*)lds; LAS float* Ot = red + 512;
    const int b = su >> 3, h = su & 7, row = MP + b, col0 = h * 128, v = tid & 127, kq = tid >> 7;
    const size_t so = (size_t)((b * 2 + layer) * 8 + h) * 16384;
    const GAS float* S0 = S0g + so; GAS float* S1 = out + OST_S + so;
    const float vv = bf2f(VH[(size_t)row * D + col0 + v]); float acc = 0.f;
#pragma unroll 8
    for (int i = 0; i < 32; ++i) { const int k = 32 * kq + i; const size_t go = (size_t)row * D + col0 + k;
        const float f = __expf(LF[go]), q = bf2f(QH[go]);
        const float sn = f * (S0[k * 128 + v] - vv) + vv; S1[k * 128 + v] = sn; acc += q * sn; }
    red[kq * 128 + v] = acc; __syncthreads();
    if (tid < 128) Ot[tid] = (red[tid] + red[128 + tid]) + (red[256 + tid] + red[384 + tid]);
    __syncthreads();
    if (wave == 0) { const float x0 = Ot[lane], x1 = Ot[64 + lane]; const float rs = 1.0f / sqrtf(wave_sum(x0 * x0 + x1 * x1) * (1.0f / 128.0f) + EPSF);
        const size_t go = (size_t)row * D + col0 + lane;
        OG[go] = (bf16)f2bf(x0 * rs * gnorm[lane] * bf2f(GH[go])); OG[go + 64] = (bf16)f2bf(x1 * rs * gnorm[64 + lane] * bf2f(GH[go + 64])); }
    __syncthreads();
}
__device__ __forceinline__ int t5_bucket(int d) {
    if (d < 16) return d;
    int lg = 16 + (int)(logf((float)d * (1.0f / 16.0f)) / 2.0794415416798357f * 16.0f);
    return lg > 31 ? 31 : lg;
}
__device__ __forceinline__ void attn_sample_item(int wi, int jl, const GAS bf16* Q, const GAS bf16* KSH, const GAS bf16* VSH, const GAS float* ck, const GAS float* cv, GAS bf16* ATT, const GAS float* sinks, const GAS float* relb,
                                                 LAS float* pbuf, int lane) {
    const int b = wi >> 4, head = wi & 15, kv = head >> 2, row = MP + b;
    float q[64];
    { const GAS bf16* qp = Q + (size_t)row * D + head * 64;
#pragma unroll
      for (int c8 = 0; c8 < 8; ++c8) { const u32x4 w = *(const GAS u32x4*)(qp + c8 * 8);
#pragma unroll
        for (int e = 0; e < 4; ++e) { q[c8 * 8 + 2 * e] = __uint_as_float(w[e] << 16); q[c8 * 8 + 2 * e + 1] = __uint_as_float(w[e] & 0xffff0000u); } } }
    float scv[2];
#pragma unroll
    for (int hh = 0; hh < 2; ++hh) { const int jj = lane + 64 * hh; const GAS float* kp = ck + (size_t)((b * 128 + jj) * 4 + kv) * 64; float dot = 0.f;
#pragma unroll
        for (int c4 = 0; c4 < 16; ++c4) { const f32x4 kx = *(const GAS f32x4*)(kp + 4 * c4); dot += q[4 * c4] * kx[0] + q[4 * c4 + 1] * kx[1] + q[4 * c4 + 2] * kx[2] + q[4 * c4 + 3] * kx[3]; }
        scv[hh] = jj >= 1 ? dot + relb[t5_bucket(128 - jj) * 16 + head] : -1e30f; }
    float scn;
    { const GAS bf16* kp = KSH + (size_t)row * 256 + kv * 64; float dot = 0.f;
#pragma unroll
      for (int c8 = 0; c8 < 8; ++c8) { const u32x4 w = *(const GAS u32x4*)(kp + c8 * 8);
#pragma unroll
        for (int e = 0; e < 4; ++e) { dot += q[c8 * 8 + 2 * e] * __uint_as_float(w[e] << 16); dot += q[c8 * 8 + 2 * e + 1] * __uint_as_float(w[e] & 0xffff0000u); } }
      scn = dot + relb[head]; }
    const float sink = sinks[jl * 16 + head];
    const float m = fmaxf(fmaxf(sink, scn), wave_max(fmaxf(scv[0], scv[1])));
    const float p0 = __expf(scv[0] - m), p1 = __expf(scv[1] - m), pn = __expf(scn - m);
    const float lsum = wave_sum(p0 + p1) + pn + __expf(sink - m);
    pbuf[lane] = p0; pbuf[64 + lane] = p1;
    LDS_WAIT(); asm volatile("" ::: "memory");
    float o = pn * bf2f(VSH[(size_t)row * 256 + kv * 64 + lane]);
#pragma unroll 8
    for (int jj = 1; jj < 128; ++jj) o += pbuf[jj] * cv[(size_t)((b * 128 + jj) * 4 + kv) * 64 + lane];
    ATT[(size_t)row * D + head * 64 + lane] = (bf16)f2bf(o / lsum);
    LDS_WAIT(); asm volatile("" ::: "memory");
}
typedef float f32x16 __attribute__((ext_vector_type(16)));
typedef short v4i16_t __attribute__((ext_vector_type(4)));
constexpr int AT_KROW = 144, AT_VROW = 192, AT_K = 0, AT_V = 192 * AT_KROW, AT_BT = AT_V + 192 * AT_VROW, AT_BK = AT_BT + 4 * 192 * 4, AT_OST = 69632, AT_OROW = 144;
static_assert(AT_BK + 512 <= AT_OST && AT_OST + 8 * 32 * AT_OROW <= RING_BYTES, "attention LDS map");
__device__ __forceinline__ v4i16_t ds_tr16(const LAS unsigned char* p) { return __builtin_amdgcn_ds_read_tr16_b64_v4i16((LAS v4i16_t*)p); }
__device__ __forceinline__ void attn_unit_mfma(int unit, int jl, const GAS bf16* Q, const GAS bf16* KSH, const GAS bf16* VSH, GAS bf16* ATT, const GAS float* sinks, const GAS float* relb,
                                               LAS unsigned char* lds, int tid, int wave, int lane) {
    const int b = unit >> 9, kv = (unit >> 7) & 3, qb = unit & 127, t0 = qb * 64, rowbase = b * SEQ;
    LAS float* BT = (LAS float*)(lds + AT_BT); const LAS int* BK = (const LAS int*)(lds + AT_BK);
#pragma unroll
    for (int i = 0; i < 3; ++i) { const int idx = tid + 512 * i, s = idx >> 3, ch = idx & 7, sabs = t0 - 128 + s;
        u32x4 kx = (u32x4){0u, 0u, 0u, 0u}, vx = (u32x4){0u, 0u, 0u, 0u};
        if (sabs >= 0) { const size_t go = (size_t)(rowbase + sabs) * 256 + kv * 64 + ch * 8; kx = *(const GAS u32x4*)(KSH + go); vx = *(const GAS u32x4*)(VSH + go); }
        *(LAS u32x4*)(lds + AT_K + s * AT_KROW + ch * 16) = kx; *(LAS u32x4*)(lds + AT_V + s * AT_VROW + ch * 16) = vx; }
    for (int idx = tid; idx < 4 * 192; idx += 512) { const int g = idx / 192, i = idx - g * 192, dist = i - 31;
        BT[idx] = (dist >= 0 && dist < 128) ? relb[BK[dist] * 16 + kv * 4 + g] : -1e30f; }
    __syncthreads();
    const int g = wave >> 1, th = wave & 1, head = kv * 4 + g, qi = lane & 31, h = lane >> 5;
    bf16x8 qf[4];
    { const GAS bf16* qp = Q + (size_t)(rowbase + t0 + 32 * th + qi) * D + head * 64 + 8 * h;
#pragma unroll
      for (int s = 0; s < 4; ++s) qf[s] = __builtin_bit_cast(bf16x8, *(const GAS u32x4*)(qp + 16 * s)); }
    f32x16 acc[5];
#pragma unroll
    for (int kg = 0; kg < 5; ++kg) {
#pragma unroll
        for (int rg = 0; rg < 16; ++rg) { const int keyoff = (rg & 3) + 8 * (rg >> 2) + 4 * h; acc[kg][rg] = BT[g * 192 + qi + 128 - 32 * kg - keyoff + 31]; }
        const LAS unsigned char* kp = lds + AT_K + (32 * th + 32 * kg + qi) * AT_KROW + 16 * h;
#pragma unroll
        for (int s = 0; s < 4; ++s) acc[kg] = __builtin_amdgcn_mfma_f32_32x32x16_bf16(*(const LAS bf16x8*)(kp + 32 * s), qf[s], acc[kg], 0, 0, 0);
    }
    if (t0 < 128) {
#pragma unroll
        for (int kg = 0; kg < 5; ++kg)
#pragma unroll
            for (int rg = 0; rg < 16; ++rg) { const int keyoff = (rg & 3) + 8 * (rg >> 2) + 4 * h; if (t0 + 32 * th + 32 * kg + keyoff < 128) acc[kg][rg] = -1e30f; }
    }
    const float sink = sinks[jl * 16 + head];
    float m = sink;
#pragma unroll
    for (int kg = 0; kg < 5; ++kg)
#pragma unroll
        for (int rg = 0; rg < 16; ++rg) m = fmaxf(m, acc[kg][rg]);
    m = fmaxf(m, __shfl_xor(m, 32));
    float sum = 0.f;
#pragma unroll
    for (int kg = 0; kg < 5; ++kg)
#pragma unroll
        for (int rg = 0; rg < 16; ++rg) { const float p = __expf(acc[kg][rg] - m); acc[kg][rg] = p; sum += p; }
    sum += __shfl_xor(sum, 32); sum += __expf(sink - m);
    const float inv = 1.0f / sum;
    f32x16 o[2];
#pragma unroll
    for (int db = 0; db < 2; ++db)
#pragma unroll
        for (int rg = 0; rg < 16; ++rg) o[db][rg] = 0.f;
    const LAS unsigned char* vp = lds + AT_V + (32 * th + 4 * h + ((lane & 15) >> 2)) * AT_VROW + (16 * ((lane >> 4) & 1) + 4 * (lane & 3)) * 2;
#pragma unroll
    for (int kg = 0; kg < 5; ++kg)
#pragma unroll
        for (int s2 = 0; s2 < 2; ++s2) {
            u32x4 pw; pw.x = cvt_pk(acc[kg][8 * s2 + 0], acc[kg][8 * s2 + 1]); pw.y = cvt_pk(acc[kg][8 * s2 + 2], acc[kg][8 * s2 + 3]);
            pw.z = cvt_pk(acc[kg][8 * s2 + 4], acc[kg][8 * s2 + 5]); pw.w = cvt_pk(acc[kg][8 * s2 + 6], acc[kg][8 * s2 + 7]);
            const bf16x8 pb = __builtin_bit_cast(bf16x8, pw);
#pragma unroll
            for (int db = 0; db < 2; ++db) {
                const LAS unsigned char* vq = vp + (32 * kg + 16 * s2) * AT_VROW + 64 * db;
                const v4i16_t lo = ds_tr16(vq), hi = ds_tr16(vq + 8 * AT_VROW);
                const bf16x8 va = (bf16x8){lo[0], lo[1], lo[2], lo[3], hi[0], hi[1], hi[2], hi[3]};
                o[db] = __builtin_amdgcn_mfma_f32_32x32x16_bf16(va, pb, o[db], 0, 0, 0);
            }
        }
    LAS unsigned char* stg = lds + AT_OST + wave * (32 * AT_OROW);
#pragma unroll
    for (int db = 0; db < 2; ++db)
#pragma unroll
        for (int r4 = 0; r4 < 4; ++r4) { u32x2 w; w.x = cvt_pk(o[db][4 * r4] * inv, o[db][4 * r4 + 1] * inv); w.y = cvt_pk(o[db][4 * r4 + 2] * inv, o[db][4 * r4 + 3] * inv);
            *(LAS u32x2*)(stg + qi * AT_OROW + (32 * db + 8 * r4 + 4 * h) * 2) = w; }
    LDS_WAIT(); asm volatile("" ::: "memory");
#pragma unroll
    for (int i = 0; i < 4; ++i) { const int row = i * 8 + (lane >> 3), ch = lane & 7; const u32x4 v = *(const LAS u32x4*)(stg + row * AT_OROW + ch * 16);
        *(GAS u32x4*)(ATT + (size_t)(rowbase + t0 + 32 * th + row) * D + head * 64 + ch * 8) = v; }
    __syncthreads();
}
constexpr int SM_QT = 0, SM_KD = 4352, SM_KTT = 8704, SM_VT = 13824, SM_DL = 18944, SM_OT = 19456, SM_ROW = 272, SM_TROW = 40;
__device__ __forceinline__ f32x4 mfma16(bf16x8 a, bf16x8 b, f32x4 c) { return __builtin_amdgcn_mfma_f32_16x16x32_bf16(a, b, c, 0, 0, 0); }
template <bool PASS_C>
__device__ __forceinline__ void scan_unit_mfma(int unit, const GAS bf16* QH, const GAS float* LF, const GAS bf16* VH, const GAS bf16* GH, GAS float* U, GAS float* DLOG, GAS bf16* OG, const GAS float* gnorm,
                                               LAS unsigned char* lds, int tid, int wave, int lane) {
    const int b = unit >> 7, hh = (unit >> 4) & 7, sc = unit & 15, row0 = b * SEQ + sc * SCT, col0 = hh * 128;
    const int r = lane & 15, g = lane >> 4, k = tid & 127, p = tid >> 7;
    f32x4 sacc[8];
#pragma unroll
    for (int kt = 0; kt < 8; ++kt)
#pragma unroll
        for (int rg = 0; rg < 4; ++rg) sacc[kt][rg] = PASS_C ? U[(size_t)unit * 16384 + (16 * kt + 4 * g + rg) * 128 + 16 * wave + r] : 0.f;
    const int pk = (k >> 5) * 32 + ((k >> 2) & 3) * 8 + 4 * ((k >> 4) & 1) + (k & 3);
    const int tn = tid >> 5, vn = 4 * (tid & 31);
    f32x4 gnv = (f32x4){0.f, 0.f, 0.f, 0.f}; if (PASS_C) gnv = *(const GAS f32x4*)(gnorm + vn);
    float lfr[16]; unsigned short qr[4], vr[4]; u32x2 gater = (u32x2){0u, 0u};
    float dsum = 0.f;
    { const size_t go = (size_t)row0 * D + col0 + k;
#pragma unroll
      for (int t = 0; t < 16; ++t) lfr[t] = LF[go + (size_t)t * D];
#pragma unroll
      for (int i = 0; i < 4; ++i) { vr[i] = VH[go + (size_t)(4 * p + i) * D]; qr[i] = PASS_C ? QH[go + (size_t)(4 * p + i) * D] : (unsigned short)0; } }
    constexpr int NSTEP = SCT / 16;
    for (int st = 0; st <= NSTEP; ++st) {
        if (st < NSTEP) {
            float gs[4];
#pragma unroll
            for (int gi = 0; gi < 4; ++gi) gs[gi] = (lfr[4 * gi] + lfr[4 * gi + 1]) + (lfr[4 * gi + 2] + lfr[4 * gi + 3]);
            const float bL = (gs[0] + gs[1]) + (gs[2] + gs[3]); dsum += bL;
            float run = (p > 0 ? gs[0] : 0.f) + (p > 1 ? gs[1] : 0.f) + (p > 2 ? gs[2] : 0.f);
            u32x2 ktw, vtw; unsigned short kt4[4];
#pragma unroll
            for (int i = 0; i < 4; ++i) { const int t = 4 * p + i; const float lfo = p == 0 ? lfr[i] : (p == 1 ? lfr[4 + i] : (p == 2 ? lfr[8 + i] : lfr[12 + i]));
                run += lfo; const float bct = run; const float kk = 1.0f - __expf(lfo);
                kt4[i] = (unsigned short)f2bf(kk * __expf(bL - bct));
                if (PASS_C) { *(LAS unsigned short*)(lds + SM_QT + t * SM_ROW + pk * 2) = (unsigned short)f2bf(bf2f(qr[i]) * __expf(bct));
                              *(LAS unsigned short*)(lds + SM_KD + t * SM_ROW + pk * 2) = (unsigned short)f2bf(kk * __expf(fminf(-bct, 60.0f))); } }
            ktw.x = (unsigned)kt4[0] | ((unsigned)kt4[1] << 16); ktw.y = (unsigned)kt4[2] | ((unsigned)kt4[3] << 16);
            vtw.x = (unsigned)vr[0] | ((unsigned)vr[1] << 16); vtw.y = (unsigned)vr[2] | ((unsigned)vr[3] << 16);
            *(LAS u32x2*)(lds + SM_KTT + k * SM_TROW + 8 * p) = ktw; *(LAS u32x2*)(lds + SM_VT + k * SM_TROW + 8 * p) = vtw;
            if (p == 0) *(LAS float*)(lds + SM_DL + 4 * k) = __expf(bL);
        }
        if (PASS_C && st > 0) {
            const f32x4 x = *(const LAS f32x4*)(lds + SM_OT + (tn * 128 + vn) * 4);
            float ss = (x[0] * x[0] + x[1] * x[1]) + (x[2] * x[2] + x[3] * x[3]);
#pragma unroll
            for (int o = 1; o < 32; o <<= 1) ss += __shfl_xor(ss, o);
            const float rs = 1.0f / sqrtf(ss * (1.0f / 128.0f) + EPSF);
            u32x2 w; w.x = cvt_pk(x[0] * rs * gnv[0] * __uint_as_float(gater.x << 16), x[1] * rs * gnv[1] * __uint_as_float(gater.x & 0xffff0000u));
            w.y = cvt_pk(x[2] * rs * gnv[2] * __uint_as_float(gater.y << 16), x[3] * rs * gnv[3] * __uint_as_float(gater.y & 0xffff0000u));
            *(GAS u32x2*)(OG + (size_t)(row0 + 16 * (st - 1) + tn) * D + col0 + vn) = w;
        }
        if (st == NSTEP) break;
        __syncthreads();
        if (st + 1 < NSTEP) { const size_t go = (size_t)(row0 + 16 * (st + 1)) * D + col0 + k;
#pragma unroll
            for (int t = 0; t < 16; ++t) lfr[t] = LF[go + (size_t)t * D];
#pragma unroll
            for (int i = 0; i < 4; ++i) { vr[i] = VH[go + (size_t)(4 * p + i) * D]; if (PASS_C) qr[i] = QH[go + (size_t)(4 * p + i) * D]; } }
        if (PASS_C) gater = *(const GAS u32x2*)(GH + (size_t)(row0 + 16 * st + tn) * D + col0 + vn);
        bf16x8 vfr; { const u32x2 x = *(const LAS u32x2*)(lds + SM_VT + (16 * wave + r) * SM_TROW + 8 * g); vfr = __builtin_bit_cast(bf16x8, (u32x4){x.x, x.y, 0u, 0u}); }
        if (PASS_C) {
            f32x4 o = (f32x4){0.f, 0.f, 0.f, 0.f}, at = (f32x4){0.f, 0.f, 0.f, 0.f};
#pragma unroll
            for (int ks = 0; ks < 4; ++ks) {
                const bf16x8 qf = *(const LAS bf16x8*)(lds + SM_QT + r * SM_ROW + ks * 64 + g * 16), kf = *(const LAS bf16x8*)(lds + SM_KD + r * SM_ROW + ks * 64 + g * 16);
                u32x4 sw; sw.x = cvt_pk(sacc[2 * ks][0], sacc[2 * ks][1]); sw.y = cvt_pk(sacc[2 * ks][2], sacc[2 * ks][3]); sw.z = cvt_pk(sacc[2 * ks + 1][0], sacc[2 * ks + 1][1]); sw.w = cvt_pk(sacc[2 * ks + 1][2], sacc[2 * ks + 1][3]);
                o = mfma16(qf, __builtin_bit_cast(bf16x8, sw), o);
                at = mfma16(kf, qf, at);
            }
#pragma unroll
            for (int rg = 0; rg < 4; ++rg) if (4 * g + rg > r) at[rg] = 0.f;
            u32x4 aw; aw.x = cvt_pk(at[0], at[1]); aw.y = cvt_pk(at[2], at[3]); aw.z = 0u; aw.w = 0u;
            o = mfma16(__builtin_bit_cast(bf16x8, aw), vfr, o);
#pragma unroll
            for (int rg = 0; rg < 4; ++rg) *(LAS float*)(lds + SM_OT + ((4 * g + rg) * 128 + 16 * wave + r) * 4) = o[rg];
        }
#pragma unroll
        for (int kt = 0; kt < 8; ++kt) {
            const f32x4 dl = *(const LAS f32x4*)(lds + SM_DL + (16 * kt + 4 * g) * 4);
            const u32x2 x = *(const LAS u32x2*)(lds + SM_KTT + (16 * kt + r) * SM_TROW + 8 * g);
            sacc[kt] = mfma16(__builtin_bit_cast(bf16x8, (u32x4){x.x, x.y, 0u, 0u}), vfr, sacc[kt] * dl);
        }
        __syncthreads();
    }
    if (!PASS_C) {
#pragma unroll
        for (int kt = 0; kt < 8; ++kt)
#pragma unroll
            for (int rg = 0; rg < 4; ++rg) U[(size_t)unit * 16384 + (16 * kt + 4 * g + rg) * 128 + 16 * wave + r] = sacc[kt][rg];
        if (p == 0) DLOG[unit * 128 + k] = dsum;
    }
    __syncthreads();
}
__global__ void __launch_bounds__(NWAVES * 64, 2) yoco_fwd(Args args) {
    extern __shared__ __attribute__((aligned(16))) unsigned char lds_raw[];
    LAS unsigned char* lds = (LAS unsigned char*)lds_raw;
    volatile LAS unsigned* MISC = (volatile LAS unsigned*)(lds + MISC_OFF);
    const int tid0 = threadIdx.x, G0 = gridDim.x, bx0 = blockIdx.x;
    const int tid = tid0;
    gu32* ctl = (gu32*)(args.ws + WS_CTL);
    for (int u = tid; u < (LDS_BYTES - LDSCTL_OFF) / 4; u += NWAVES * 64) ((LAS unsigned*)(lds + LDSCTL_OFF))[u] = 0u;
    __syncthreads();
    XcdBarrier bar = xcd_barrier_post((unsigned*)(ctl + CW_BAR), MISC + 8);
#define GRID_BAR() xcd_barrier(bar)

    volatile LAS unsigned long long* PT = (volatile LAS unsigned long long*)(lds + PTAB_OFF);
    if (tid < 25) PT[tid] = (unsigned long long)args.in[tid];
    if (tid == 25) PT[25] = (unsigned long long)args.out;
    if (tid == 26) PT[26] = (unsigned long long)args.ws;
    __syncthreads();
#define PF(i) ((const GAS float*)ldptr(PT, (i)))
#define POUT ((GAS float*)ldptr(PT, 25))
#define PWS ((GAS unsigned char*)ldptr(PT, 26))

    enum { T_P0, T_NORMX, T_INPROJ, T_SCANA, T_SCANB, T_SCANC, T_QPROJ, T_ATTN, T_RES, T_NORM, T_FFN1, T_KV };
    constexpr int NPH = 2 + 2 * 9 + 1 + 2 * 7;
#pragma unroll 1
    for (int ph = 0; ph < NPH; ++ph) {
        int tid = tid0, G = G0, bx = bx0; asm volatile("" : "+v"(tid)); asm volatile("" : "+s"(G), "+s"(bx));
        const int lane = tid & 63, wave = __builtin_amdgcn_readfirstlane(tid >> 6);
        const int vcu = (G % 8 == 0) ? (bx % 8) * (G / 8) + bx / 8 : bx, gw = vcu * NWAVES + wave, NGW = G * NWAVES;
        int type, l = 0, half = 0;
#ifdef PROBE_A
        if (bx0 == 0 && tid0 == 0) ((volatile LAS unsigned long long*)(lds + LDSCTL_OFF + 2048))[ph] = __builtin_amdgcn_s_memrealtime();
#endif
        if (ph == 0) type = T_P0;
        else if (ph == 1) type = T_NORMX;
        else { const int p = ph - 2;
            if (p < 18) { l = p >= 9 ? 1 : 0; const int st = p - 9 * l;
                type = st == 0 ? T_INPROJ : st == 1 ? T_SCANA : st == 2 ? T_SCANB : st == 3 ? T_SCANC : st == 4 ? T_RES : st == 5 ? T_NORM : st == 6 ? T_FFN1 : st == 7 ? T_RES : T_NORM; half = st >= 6 ? 1 : 0; }
            else if (p == 18) { type = T_KV; l = 1; }
            else { const int p2 = p - 19; l = 2 + (p2 >= 7 ? 1 : 0); const int st = p2 - 7 * (l - 2);
                type = st == 0 ? T_QPROJ : st == 1 ? T_ATTN : st == 2 ? T_RES : st == 3 ? T_NORM : st == 4 ? T_FFN1 : st == 5 ? T_RES : T_NORM; half = st >= 4 ? 1 : 0; } }
        if (type == T_P0) {
            p0_ada(PT, lds, vcu, G, tid, wave, lane);
            p0_transposes(PT, lds, gw, NGW, wave, lane);
        } else if (type == T_NORMX) {
            GAS unsigned char* ws = PWS; const GAS float* ADA = (const GAS float*)(ws + WS_ADA);
            norm_pass<1>(gw, NGW, lane, nullptr, PF(I_XP), PF(I_XS), (GAS float*)(ws + WS_H), PF(I_NORMW), ADA + 0 * D, ADA + 1 * D, ADAW, (GAS bf16*)(ws + WS_XN), nullptr, nullptr, nullptr, 0, nullptr, nullptr);
        } else if (type == T_INPROJ) {
            GAS unsigned char* ws = PWS; const GAS float* lb = PF(I_LB);
            pg8::Gemm g{(const GAS bf16*)(ws + WS_XN), (const GAS bf16*)(ws + WS_WIN) + (size_t)l * WIN_SZ, MP, 4096, D}; pg8::StaticOrder S; S.init(MP, 4096, G, bx);
            EpiInProj E{ws, lb, lb + D, l};
            pg8::gemm_phase<EpiInProj, pg8::StaticOrder, true, true>(lds + RING_OFF, g, S, E, tid);
            { SEpiInProj SE{ws, lb, lb + D, l}; skinny_gemm<1>(g.A + (size_t)MP * D, g.Bt, 4096, D, SE, lds, vcu, G, wave, lane); }
        } else if (type == T_SCANA) {
            GAS unsigned char* ws = PWS; const GAS float* gn = PF(I_GNORM) + l * 128;
            for (int u = vcu; u < NUNIT; u += G) scan_unit_mfma<false>(u, (const GAS bf16*)(ws + WS_QH), (const GAS float*)(ws + WS_LF), (const GAS bf16*)(ws + WS_VH), (const GAS bf16*)(ws + WS_GH), (GAS float*)(ws + WS_SCAN), (GAS float*)(ws + WS_DLOG), (GAS bf16*)(ws + WS_OG), gn, lds, tid, wave, lane);
            const GAS float* st0 = PF(I_STATE); GAS float* out = POUT;
            for (int su = vcu; su < MS * 8; su += G) scan_sample_unit(su, l, (const GAS bf16*)(ws + WS_QH), (const GAS float*)(ws + WS_LF), (const GAS bf16*)(ws + WS_VH), (const GAS bf16*)(ws + WS_GH), st0, out, (GAS bf16*)(ws + WS_OG), gn, lds, tid, wave, lane);
        } else if (type == T_SCANB) {
            GAS unsigned char* ws = PWS; scan_combine(l, (GAS float*)(ws + WS_SCAN), (const GAS float*)(ws + WS_DLOG), POUT, vcu * NWAVES * 64 + tid, G * NWAVES * 64);
        } else if (type == T_SCANC) {
            GAS unsigned char* ws = PWS; const GAS float* gn = PF(I_GNORM) + l * 128;
            for (int u = vcu; u < NUNIT; u += G) scan_unit_mfma<true>(u, (const GAS bf16*)(ws + WS_QH), (const GAS float*)(ws + WS_LF), (const GAS bf16*)(ws + WS_VH), (const GAS bf16*)(ws + WS_GH), (GAS float*)(ws + WS_SCAN), (GAS float*)(ws + WS_DLOG), (GAS bf16*)(ws + WS_OG), gn, lds, tid, wave, lane);
        } else if (type == T_QPROJ) {
            GAS unsigned char* ws = PWS;
            pg8::Gemm g{(const GAS bf16*)(ws + WS_XN), (const GAS bf16*)(ws + WS_WQ) + (size_t)(l - 2) * WOA_SZ, MP, D, D}; pg8::StaticOrder S; S.init(MP, D, G, bx);
            EpiQ E{(GAS bf16*)(ws + WS_QH)};
            pg8::gemm_phase<EpiQ, pg8::StaticOrder, true, true>(lds + RING_OFF, g, S, E, tid);
            { SEpiQ SE{(GAS bf16*)(ws + WS_QH)}; skinny_gemm<4>(g.A + (size_t)MP * D, g.Bt, D, D, SE, lds, vcu, G, wave, lane); }
        } else if (type == T_ATTN) {
            GAS unsigned char* ws = PWS; const GAS float* sinks = PF(I_SINKS); const GAS float* relb = PF(I_RELB); const int jl = l - 2;
            if (tid < 128) ((LAS int*)(lds + AT_BK))[tid] = t5_bucket(tid);
            __syncthreads();
            for (int it = vcu; it < 1024; it += G) attn_unit_mfma(it, jl, (const GAS bf16*)(ws + WS_QH), (const GAS bf16*)(ws + WS_KSH), (const GAS bf16*)(ws + WS_VSH), (GAS bf16*)(ws + WS_OG), sinks, relb, lds, tid, wave, lane);
            LAS float* pbuf = (LAS float*)(lds + 110592 + wave * 512);
            const GAS float* ck = PF(I_CK); const GAS float* cv = PF(I_CV);
            for (int wi = gw; wi < MS * 16; wi += NGW) attn_sample_item(wi, jl, (const GAS bf16*)(ws + WS_QH), (const GAS bf16*)(ws + WS_KSH), (const GAS bf16*)(ws + WS_VSH), ck, cv, (GAS bf16*)(ws + WS_OG), sinks, relb, pbuf, lane);
        } else if (type == T_FFN1) {
            GAS unsigned char* ws = PWS;
            pg8::Gemm g{(const GAS bf16*)(ws + WS_XN), (const GAS bf16*)(ws + WS_WF1) + (size_t)l * WF1_SZ, MP, NFF2, D}; pg8::StaticOrder S; S.init(MP, NFF2, G, bx);
            EpiSwiGLU E{(GAS bf16*)(ws + WS_ACT)};
            pg8::gemm_phase<EpiSwiGLU, pg8::StaticOrder, true, true>(lds + RING_OFF, g, S, E, tid);
            { SEpiSwiGLU SE{(GAS bf16*)(ws + WS_ACT)}; skinny_gemm<1>(g.A + (size_t)MP * D, g.Bt, NFF2, D, SE, lds, vcu, G, wave, lane); }
        } else if (type == T_RES) {
            GAS unsigned char* ws = PWS;
            const GAS bf16* Ap = half == 0 ? (const GAS bf16*)(ws + WS_OG) : (const GAS bf16*)(ws + WS_ACT);
            const GAS bf16* Bp = half == 0 ? (l < 2 ? (const GAS bf16*)(ws + WS_WOA) + (size_t)l * WOA_SZ : (const GAS bf16*)(ws + WS_WOB) + (size_t)(l - 2) * WOA_SZ) : (const GAS bf16*)(ws + WS_WF2) + (size_t)l * WF2_SZ;
            pg8::Gemm g{Ap, Bp, MP, D, half == 0 ? D : DFF}; pg8::StaticOrder S; S.init(MP, D, G, bx);
            EpiRes E{(GAS float*)(ws + WS_H), (const GAS float*)(ws + WS_ADA) + (size_t)l * NCOND * ADAW + (half == 0 ? 2 : 5) * D};
            pg8::gemm_phase<EpiRes, pg8::StaticOrder, true, true>(lds + RING_OFF, g, S, E, tid);
            { SEpiRes SE{E.H, E.gate}; skinny_gemm<4>(Ap + (size_t)MP * g.K, Bp, D, g.K, SE, lds, vcu, G, wave, lane); }
        } else if (type == T_NORM) {
            GAS unsigned char* ws = PWS; const GAS float* NW = PF(I_NORMW); const GAS float* ADAl = (const GAS float*)(ws + WS_ADA) + (size_t)l * NCOND * ADAW; const GAS float* ADAn = ADAl + NCOND * ADAW;
            const GAS float* Hc = (const GAS float*)(ws + WS_H); GAS bf16* XN = (GAS bf16*)(ws + WS_XN);
            if (half == 0) norm_pass<0>(gw, NGW, lane, Hc, nullptr, nullptr, nullptr, NW + (l * 2 + 1) * D, ADAl + 3 * D, ADAl + 4 * D, ADAW, XN, nullptr, nullptr, nullptr, 0, nullptr, nullptr);
            else if (l == 3) norm_pass<3>(gw, NGW, lane, Hc, nullptr, nullptr, nullptr, PF(I_FNORM), nullptr, nullptr, 0, nullptr, nullptr, nullptr, nullptr, 0, nullptr, POUT);
            else if (l == 1) norm_pass<2>(gw, NGW, lane, Hc, nullptr, nullptr, nullptr, NW + ((l + 1) * 2) * D, ADAn + 0 * D, ADAn + 1 * D, ADAW, XN,
                                          PF(I_KVNORM), (const GAS float*)(ws + WS_ADAKV), (const GAS float*)(ws + WS_ADAKV) + D, 2048, (GAS bf16*)(ws + WS_XNKV), nullptr);
            else norm_pass<0>(gw, NGW, lane, Hc, nullptr, nullptr, nullptr, NW + ((l + 1) * 2) * D, ADAn + 0 * D, ADAn + 1 * D, ADAW, XN, nullptr, nullptr, nullptr, 0, nullptr, nullptr);
        } else {
            { GAS unsigned char* ws = PWS; GAS float* out = POUT;
              pg8::Gemm g{(const GAS bf16*)(ws + WS_XNKV), (const GAS bf16*)(ws + WS_WKV), MP, 512, D}; pg8::StaticOrder S; S.init(MP, 512, G, bx);
              EpiKV E{(GAS bf16*)(ws + WS_KSH), (GAS bf16*)(ws + WS_VSH), out};
              pg8::gemm_phase<EpiKV, pg8::StaticOrder, true, true>(lds + RING_OFF, g, S, E, tid);
              { SEpiKV SE{E.KSH, E.VSH, out}; skinny_gemm<4>(g.A + (size_t)MP * D, g.Bt, 512, D, SE, lds, vcu, G, wave, lane); } }
            { GAS float* out = POUT; const GAS float* ck = PF(I_CK); const GAS float* cv = PF(I_CV);
              const int gt = vcu * NWAVES * 64 + tid, NGT = G * NWAVES * 64;
              for (int e = gt; e < MS * 127 * 64; e += NGT) { const int b = e / (127 * 64), r = e % (127 * 64);
                  *(GAS f32x4*)(out + OCK_S + (size_t)b * 32768 + 4 * r) = *(const GAS f32x4*)(ck + (size_t)b * 32768 + 256 + 4 * r);
                  *(GAS f32x4*)(out + OCV_S + (size_t)b * 32768 + 4 * r) = *(const GAS f32x4*)(cv + (size_t)b * 32768 + 256 + 4 * r); } }
        }
#ifdef PROBE_A
        if (bx0 == 0 && tid0 == 0) { ((volatile LAS unsigned*)(lds + LDSCTL_OFF + 2048 + 512))[ph] = (unsigned)(type == T_RES ? 100 + half : type == T_NORM ? 200 + half : type);
                                     ((volatile LAS unsigned long long*)(lds + LDSCTL_OFF + 2048 + 1024))[ph] = __builtin_amdgcn_s_memrealtime(); }
#endif
        GRID_BAR();
    }
#ifdef PROBE_A
    if (bx0 == 0) {
        volatile LAS unsigned long long* TS = (volatile LAS unsigned long long*)(lds + LDSCTL_OFF + 2048); volatile LAS unsigned* TY = (volatile LAS unsigned*)(lds + LDSCTL_OFF + 2048 + 512);
        volatile LAS unsigned long long* TE = (volatile LAS unsigned long long*)(lds + LDSCTL_OFF + 2048 + 1024);
        volatile LAS float* RES = (volatile LAS float*)(lds + LDSCTL_OFF + 2048 + 1536);
        if (tid0 == 0) { const unsigned long long tend = __builtin_amdgcn_s_memrealtime(); unsigned long long ta = 0, tb = 0;
            for (int ph = 0; ph < NPH; ++ph) { const unsigned long long full = (ph + 1 < NPH ? TS[ph + 1] : tend) - TS[ph], work = TE[ph] - TS[ph]; const int ty = (int)TY[ph];
                const unsigned long long va = PROBE_A >= 1000 ? ((ty == PROBE_A - 1000) ? work : 0ull) : ((ty == PROBE_A) ? full : 0ull);
                const unsigned long long vb = PROBE_B >= 1000 ? ((ty == PROBE_B - 1000) ? work : 0ull) : ((ty == PROBE_B) ? full : 0ull);
                ta += va; tb += vb; }
            RES[0] = sqrtf((float)ta * 0.01f * 1e-5f); RES[1] = 1.0f + (float)tb * 0.01f * 0.01f; }
        __syncthreads();
        GAS float* out = POUT; const float dl = RES[0], da = RES[1];
        for (int i = tid0; i < 65536; i += NWAVES * 64) out[OCK_P + i] *= (1.0f + dl);
        if (tid0 == 0) out[0] += da;
    }
#endif
}

extern "C" void kernel_launch(void* const* d_in, const int* in_sizes, int n_in, void* d_out, int out_size, void* d_ws, size_t ws_size, hipStream_t stream) {
    static int grid = 0;
    if (grid == 0) {
        if (n_in != 25 || (size_t)out_size != OUT_TOTAL || ws_size < WS_END) { fprintf(stderr, "kernel_launch: unexpected problem: n_in %d out %d ws %zu (need >= %zu)\n", n_in, out_size, ws_size, (size_t)WS_END); grid = -1; return; }
        int dev = 0, cus = 0, per_cu = 0;
        if (hipGetDevice(&dev) != hipSuccess || hipDeviceGetAttribute(&cus, hipDeviceAttributeMultiprocessorCount, dev) != hipSuccess) { fprintf(stderr, "kernel_launch: device query failed\n"); grid = -1; return; }
        if (hipFuncSetAttribute((const void*)yoco_fwd, hipFuncAttributeMaxDynamicSharedMemorySize, LDS_BYTES) != hipSuccess) { fprintf(stderr, "kernel_launch: hipFuncSetAttribute failed\n"); grid = -1; return; }
        if (hipOccupancyMaxActiveBlocksPerMultiprocessor(&per_cu, (const void*)yoco_fwd, NWAVES * 64, LDS_BYTES) != hipSuccess || per_cu < 1)
            fprintf(stderr, "kernel_launch: note: occupancy query reports %d workgroups per CU\n", per_cu);
        (void)hipGetLastError();
        grid = cus;
    }
    if (grid < 0) return;
    if (hipMemsetAsync((char*)d_ws + WS_CTL, 0, CTL_ZERO_BYTES, stream) != hipSuccess) { fprintf(stderr, "kernel_launch: hipMemsetAsync failed\n"); return; }
    Args a{};
    for (int i = 0; i < 25; ++i) a.in[i] = (const GAS float*)d_in[i];
    a.out = (GAS float*)d_out; a.ws = (GAS unsigned char*)d_ws;
    hipLaunchKernelGGL(yoco_fwd, dim3(grid), dim3(NWAVES * 64), LDS_BYTES, stream, a);
    const hipError_t le = hipPeekAtLastError();
    if (le != hipSuccess) fprintf(stderr, "kernel_launch: launch failed: %s\n", hipGetErrorName(le));
}
```
